# Optimizing an MI355X kernel written in HIP

```python
import jax
import jax.numpy as jnp
from jax import lax
import numpy as np


D_MODEL = 1024
BATCH = 4
SEQ = 4096
DEPTH = 1

D_MIX = D_MODEL
RMS_EPS = 1e-6
MLSTM_HEADS = 4
MLSTM_DQK = 128
MLSTM_DV = 128
MLSTM_CHUNK = 64
MLA_HEADS = 4
MLA_Q_RANK = 256
MLA_KV_RANK = 128
MLA_NOPE = 128
MLA_ROPE = 64
MLA_DV = 128
MLA_DQK = MLA_NOPE + MLA_ROPE
ATTN_Q_BLOCK = 128
ROPE_THETA = 10000.0
PEER_HEADS = 8
PEER_N_KEYS = 128
PEER_N_EXPERTS = PEER_N_KEYS * PEER_N_KEYS
PEER_D_KEY = 256
PEER_TOPK = 16
PEER_TOKEN_BLOCK = 128
IN_SPLITS = (
    MLSTM_HEADS * MLSTM_DQK,
    MLSTM_HEADS * MLSTM_DQK,
    MLSTM_HEADS * MLSTM_DV,
    MLSTM_HEADS * MLSTM_DV,
    MLSTM_HEADS,
    MLSTM_HEADS,
    MLA_Q_RANK,
    MLA_KV_RANK,
    MLA_ROPE,
)
D_IN = sum(IN_SPLITS)

kernel_name = 'hybrid_mlstm_mla_peer_layer'


def rms_norm(x, g):
    xf = x.astype(jnp.float32)
    y = xf * lax.rsqrt(jnp.mean(xf * xf, axis=-1, keepdims=True) + RMS_EPS)
    return (y * g.astype(jnp.float32)).astype(x.dtype)


def mlstm_group(mq, mk, mv, mo, mi, mf, b_i, b_f, norm_g):
    B, S, _ = mq.shape
    H, L = MLSTM_HEADS, MLSTM_CHUNK
    NC = S // L
    f32 = jnp.float32

    def heads(t, d):
        return t.reshape(B, S, H, d).transpose(0, 2, 1, 3).astype(f32)

    q = heads(mq, MLSTM_DQK)
    k = heads(mk, MLSTM_DQK) * (MLSTM_DQK ** -0.5)
    v = heads(mv, MLSTM_DV)
    i_pre = jnp.moveaxis((mi + b_i).astype(f32), -1, 1)
    log_f = jax.nn.log_sigmoid(jnp.moveaxis((mf + b_f).astype(f32), -1, 1))

    def to_chunks(t):
        return jnp.moveaxis(t.reshape(B, H, NC, L, *t.shape[3:]), 2, 0)

    causal = jnp.tril(jnp.ones((L, L), dtype=bool))

    def chunk_step(carry, xs):
        C, n, m = carry
        qc, kc, vc, ic, fc = xs
        b = jnp.cumsum(fc, axis=-1)
        a = b + m[..., None]
        D = b[..., :, None] - b[..., None, :] + ic[..., None, :]
        D = jnp.where(causal, D, -jnp.inf)
        m_t = jnp.maximum(a, jnp.max(D, axis=-1))
        Dw = jnp.exp(D - m_t[..., None])
        aw = jnp.exp(a - m_t)
        s = jnp.einsum('bhtd,bhsd->bhts', qc, kc) * Dw
        num = aw[..., None] * jnp.einsum('bhtd,bhde->bhte', qc, C) + jnp.einsum('bhts,bhse->bhte', s, vc)
        den = aw * jnp.einsum('bhtd,bhd->bht', qc, n) + jnp.sum(s, axis=-1)
        h = num / jnp.maximum(jnp.abs(den), jnp.exp(-m_t))[..., None]
        bL = b[..., -1]
        g = bL[..., None] - b + ic
        m_new = jnp.maximum(bL + m, jnp.max(g, axis=-1))
        decay = jnp.exp(bL + m - m_new)
        w = jnp.exp(g - m_new[..., None])
        C_new = decay[..., None, None] * C + jnp.einsum('bhs,bhsd,bhse->bhde', w, kc, vc)
        n_new = decay[..., None] * n + jnp.einsum('bhs,bhsd->bhd', w, kc)
        return (C_new, n_new, m_new), h

    init = (jnp.zeros((B, H, MLSTM_DQK, MLSTM_DV), f32),
            jnp.zeros((B, H, MLSTM_DQK), f32),
            jnp.zeros((B, H), f32))
    xs = (to_chunks(q), to_chunks(k), to_chunks(v), to_chunks(i_pre), to_chunks(log_f))
    _, h = lax.scan(chunk_step, init, xs)
    h = jnp.moveaxis(h, 0, 2).reshape(B, H, S, MLSTM_DV).transpose(0, 2, 1, 3)
    h = rms_norm(h, norm_g.reshape(H, MLSTM_DV)).reshape(B, S, H * MLSTM_DV)
    return (jax.nn.sigmoid(mo.astype(f32)) * h).astype(mq.dtype)


def apply_rope(t, cos, sin):
    nope, rp = t[..., :MLA_NOPE], t[..., MLA_NOPE:]
    half = MLA_ROPE // 2
    r1, r2 = rp[..., :half], rp[..., half:]
    rot = jnp.concatenate([r1 * cos - r2 * sin, r1 * sin + r2 * cos], axis=-1)
    return jnp.concatenate([nope, rot], axis=-1)


def mla_group(cq, ckv, kr, positions, cq_g, w_uq, ckv_g, w_ukv, q_g, k_g):
    B, S, _ = cq.shape
    H = MLA_HEADS
    f32 = jnp.float32
    q = (rms_norm(cq, cq_g) @ w_uq).reshape(B, S, H, MLA_DQK)
    kv = (rms_norm(ckv, ckv_g) @ w_ukv).reshape(B, S, H, MLA_NOPE + MLA_DV)
    k_nope, v = kv[..., :MLA_NOPE], kv[..., MLA_NOPE:]
    k_rope = jnp.broadcast_to(kr[:, :, None, :], (B, S, H, MLA_ROPE))
    k = jnp.concatenate([k_nope, k_rope], axis=-1)
    q = rms_norm(q, q_g)
    k = rms_norm(k, k_g)
    inv_freq = ROPE_THETA ** (-jnp.arange(0, MLA_ROPE, 2, dtype=f32) / MLA_ROPE)
    ang = positions.astype(f32)[..., None] * inv_freq
    cos = jnp.cos(ang)[:, :, None, :].astype(q.dtype)
    sin = jnp.sin(ang)[:, :, None, :].astype(q.dtype)
    q = apply_rope(q, cos, sin).transpose(0, 2, 1, 3)
    k = apply_rope(k, cos, sin).transpose(0, 2, 1, 3)
    v = v.transpose(0, 2, 1, 3)
    QB = ATTN_Q_BLOCK
    NB = S // QB
    scale = MLA_DQK ** -0.5
    key_pos = jnp.arange(S)

    def attend(args):
        q_blk, bi = args
        sc = jnp.einsum('bhqd,bhkd->bhqk', q_blk, k).astype(f32) * scale
        q_pos = bi * QB + jnp.arange(QB)
        sc = jnp.where(key_pos[None, :] <= q_pos[:, None], sc, -jnp.inf)
        p = jax.nn.softmax(sc, axis=-1).astype(v.dtype)
        return jnp.einsum('bhqk,bhkd->bhqd', p, v)

    q_blocks = jnp.moveaxis(q.reshape(B, H, NB, QB, MLA_DQK), 2, 0)
    o = lax.map(attend, (q_blocks, jnp.arange(NB)))
    o = jnp.moveaxis(o, 0, 2).reshape(B, H, S, MLA_DV).transpose(0, 2, 1, 3)
    return o.reshape(B, S, H * MLA_DV)


def peer(h, w_q, keys_1, keys_2, u_table, v_table):
    B, S, D = h.shape
    T = B * S
    TB = PEER_TOKEN_BLOCK
    K = PEER_TOPK
    half = PEER_D_KEY // 2

    def block(xb):
        qry = (xb @ w_q).reshape(TB, PEER_HEADS, PEER_D_KEY)
        s1 = jnp.einsum('thd,nd->thn', qry[..., :half], keys_1)
        s2 = jnp.einsum('thd,nd->thn', qry[..., half:], keys_2)
        v1, i1 = lax.top_k(s1, K)
        v2, i2 = lax.top_k(s2, K)
        cand = (v1[..., :, None] + v2[..., None, :]).reshape(TB, PEER_HEADS, K * K)
        sc, ci = lax.top_k(cand, K)
        idx = (jnp.take_along_axis(i1, ci // K, axis=-1) * PEER_N_KEYS
               + jnp.take_along_axis(i2, ci % K, axis=-1))
        gate = jax.nn.softmax(sc.astype(jnp.float32), axis=-1)
        act = jax.nn.gelu(jnp.einsum('thed,td->the', u_table[idx], xb).astype(jnp.float32), approximate=False)
        return jnp.einsum('the,thed->td', (gate * act).astype(xb.dtype), v_table[idx])

    y = lax.map(block, h.reshape(T // TB, TB, D))
    return y.reshape(B, S, D).astype(h.dtype)


def setup_inputs(seed: int = 0) -> dict:
    key = jax.random.key(seed)
    ks = jax.random.split(key, 24)
    f32 = jnp.float32

    def normal(k, shape, scale):
        return jax.random.normal(k, shape, f32) * scale

    def gain(k, shape):
        return 1.0 + 0.02 * jax.random.normal(k, shape, f32)

    x = jax.random.normal(ks[0], (BATCH, SEQ, D_MODEL), f32)
    offsets = jax.random.randint(ks[1], (BATCH, 1), 0, 1024, dtype=jnp.int32)
    positions = (offsets + jnp.arange(SEQ, dtype=jnp.int32)[None, :]).astype(jnp.int32)
    return {
        'x': x,
        'positions': positions,
        'attn_norm_g': gain(ks[2], (DEPTH, D_MODEL)),
        'w_in': normal(ks[3], (DEPTH, D_MODEL, D_IN), D_MODEL ** -0.5),
        'b_igate': normal(ks[4], (DEPTH, MLSTM_HEADS), 0.1),
        'b_fgate': jnp.linspace(3.0, 6.0, MLSTM_HEADS, dtype=f32)[None, :] + normal(ks[5], (DEPTH, MLSTM_HEADS), 0.1),
        'mlstm_norm_g': gain(ks[6], (DEPTH, MLSTM_HEADS * MLSTM_DV)),
        'cq_norm_g': gain(ks[7], (DEPTH, MLA_Q_RANK)),
        'w_uq': normal(ks[8], (DEPTH, MLA_Q_RANK, MLA_HEADS * MLA_DQK), MLA_Q_RANK ** -0.5),
        'ckv_norm_g': gain(ks[9], (DEPTH, MLA_KV_RANK)),
        'w_ukv': normal(ks[10], (DEPTH, MLA_KV_RANK, MLA_HEADS * (MLA_NOPE + MLA_DV)), MLA_KV_RANK ** -0.5),
        'q_norm_g': gain(ks[11], (DEPTH, MLA_DQK)),
        'k_norm_g': gain(ks[12], (DEPTH, MLA_DQK)),
        'w_out': normal(ks[13], (DEPTH, D_MIX, D_MODEL), D_MIX ** -0.5),
        'ffn_norm_g': gain(ks[14], (DEPTH, D_MODEL)),
        'peer_w_q': normal(ks[15], (DEPTH, D_MODEL, PEER_HEADS * PEER_D_KEY), D_MODEL ** -0.5),
        'peer_keys_1': normal(ks[16], (DEPTH, PEER_N_KEYS, PEER_D_KEY // 2), (PEER_D_KEY // 2) ** -0.5),
        'peer_keys_2': normal(ks[17], (DEPTH, PEER_N_KEYS, PEER_D_KEY // 2), (PEER_D_KEY // 2) ** -0.5),
        'peer_u': normal(ks[18], (DEPTH, PEER_N_EXPERTS, D_MODEL), D_MODEL ** -0.5),
        'peer_v': normal(ks[19], (DEPTH, PEER_N_EXPERTS, D_MODEL), PEER_HEADS ** -0.5),
    }


def reference(x, positions, attn_norm_g, w_in, b_igate, b_fgate, mlstm_norm_g, cq_norm_g, w_uq,
              ckv_norm_g, w_ukv, q_norm_g, k_norm_g, w_out, ffn_norm_g, peer_w_q, peer_keys_1,
              peer_keys_2, peer_u, peer_v):
    split_idx = [int(s) for s in np.cumsum(IN_SPLITS)[:-1]]
    for l in range(DEPTH):
        h = rms_norm(x, attn_norm_g[l])
        proj = h @ w_in[l]
        mq, mk, mv, mo, mi, mf, cq, ckv, kr = jnp.split(proj, split_idx, axis=-1)
        y_m = mlstm_group(mq, mk, mv, mo, mi, mf, b_igate[l], b_fgate[l], mlstm_norm_g[l])
        y_a = mla_group(cq, ckv, kr, positions, cq_norm_g[l], w_uq[l], ckv_norm_g[l], w_ukv[l],
                        q_norm_g[l], k_norm_g[l])
        mixed = jnp.concatenate([y_m.astype(x.dtype), y_a.astype(x.dtype)], axis=-1)
        x = x + mixed @ w_out[l]
        h = rms_norm(x, ffn_norm_g[l])
        x = x + peer(h, peer_w_q[l], peer_keys_1[l], peer_keys_2[l], peer_u[l], peer_v[l])
    return x
```

```cpp
#include <hip/hip_runtime.h>
#include <stdint.h>

#define DI __device__ __forceinline__
typedef __attribute__((ext_vector_type(8))) short bf16x8;
typedef __attribute__((ext_vector_type(4))) float f32x4;
typedef __attribute__((ext_vector_type(16))) float f32x16;
typedef __attribute__((ext_vector_type(4))) int i32x4;
typedef __attribute__((ext_vector_type(2))) int i32x2;
typedef __attribute__((ext_vector_type(8))) int i32x8;
typedef __attribute__((ext_vector_type(2))) float f32x2;
typedef __attribute__((ext_vector_type(2))) __bf16 bf16v2;
typedef unsigned short u16;
typedef __attribute__((ext_vector_type(4))) unsigned u32x4;
typedef __attribute__((ext_vector_type(2))) unsigned u32x2;

constexpr int T_ = 16384, DM = 1024, SEQ = 4096;
constexpr int DINP = 2560;
constexpr float EPS = 1e-6f;
constexpr int NTHR = 512;

constexpr size_t OFF_BAR = 0;
constexpr size_t OFF_WIN = 16384;
constexpr size_t OFF_WUQ = OFF_WIN + 5242880;
constexpr size_t OFF_WUKV = OFF_WUQ + 393216;
constexpr size_t OFF_WOUT = OFF_WUKV + 262144;
constexpr size_t OFF_WPQ = OFF_WOUT + 2097152;
constexpr size_t OFF_K1 = OFF_WPQ + 4194304;
constexpr size_t OFF_K2 = OFF_K1 + 32768;
constexpr size_t OFF_SSQ = OFF_K2 + 32768;
constexpr size_t OFF_RA = OFF_SSQ + 1048576;
constexpr size_t OFF_U8 = OFF_RA;
constexpr size_t OFF_V8 = OFF_RA + 16777216;
constexpr size_t OFF_RSV = OFF_V8 + 8388608;
constexpr size_t OFF_RSU = OFF_RSV + 65536;
constexpr size_t OFF_RB = OFF_RA + 33554432;
constexpr size_t OFF_QM = OFF_RB;
constexpr size_t OFF_KM = OFF_RB + 16777216;
constexpr size_t OFF_OM = OFF_RB + 33554432;
constexpr size_t OFF_VT = OFF_RB + 50331648;
constexpr size_t OFF_QRY = OFF_RB;
constexpr size_t OFF_GI = OFF_RB + 67108864;
constexpr size_t OFF_GF = OFF_GI + 262144;
constexpr size_t OFF_MIX = OFF_GF + 262144;
constexpr size_t OFF_KT = OFF_MIX;
constexpr size_t OFF_LAT = OFF_MIX + 16777216;
constexpr size_t OFF_RC = OFF_MIX + 33554432;
constexpr size_t OFF_Q = OFF_RC;
constexpr size_t OFF_K = OFF_RC + 25165824;
constexpr size_t OFF_VTA = OFF_RC + 50331648;
constexpr size_t OFF_X1B = OFF_RC;
constexpr size_t OFF_RD = OFF_RC + 67108864;
constexpr size_t OFF_CST = OFF_RD;
constexpr size_t OFF_NST = OFF_RD + 33554432;
constexpr size_t OFF_MST = OFF_NST + 524288;
constexpr size_t OFF_SEL = OFF_RD;
constexpr size_t WS_NEED = OFF_MST + 4096;

struct Params {
  const float* x; const int* pos; const float* attn_g; const float* w_in; const float* b_i; const float* b_f;
  const float* mn_g; const float* cq_g; const float* w_uq; const float* ckv_g; const float* w_ukv; const float* q_g;
  const float* k_g; const float* w_out; const float* ffn_g; const float* pwq; const float* k1; const float* k2;
  const float* pu; const float* pv; float* out; char* ws;
};

DI float bf2f(short s) { return __uint_as_float(((unsigned)(unsigned short)s) << 16); }
DI unsigned pk2(float a, float b) { f32x2 v = {a, b}; bf16v2 r = __builtin_convertvector(v, bf16v2); return __builtin_bit_cast(unsigned, r); }
DI u16 f2bf(float a) { __bf16 r = (__bf16)a; return __builtin_bit_cast(u16, r); }
DI uint2 pk4(float a, float b, float c, float d) { return make_uint2(pk2(a, b), pk2(c, d)); }
DI float wave_sum(float v) { for (int o = 32; o > 0; o >>= 1) v += __shfl_xor(v, o); return v; }
DI float wave_max(float v) { for (int o = 32; o > 0; o >>= 1) v = fmaxf(v, __shfl_xor(v, o)); return v; }
DI int crow(int reg, int h) { return (reg & 3) + 8 * (reg >> 2) + 4 * h; }
#define MFMA32(a, b, c) __builtin_amdgcn_mfma_f32_32x32x16_bf16((a), (b), (c), 0, 0, 0)
#define MFMA16(a, b, c) __builtin_amdgcn_mfma_f32_16x16x32_bf16((a), (b), (c), 0, 0, 0)
DI f32x16 zero16() { f32x16 z; for (int i = 0; i < 16; ++i) z[i] = 0.f; return z; }

#define XB_TMO      128
#define XB_XCNT(j)  (256  + 64 * (j))
#define XB_XSUB(j)  (1280 + 64 * (j))
#define XB_XGEN(j)  (2304 + 64 * (j))
#define XB_TOP      3328
#define XB_TOPGEN   3392
#define XCD_BAR_WORDS 3456
#define XB_SPIN_CAP (1u << 18)
#define LAS __attribute__((address_space(3)))

DI unsigned xb_ld(unsigned* p)              { return __hip_atomic_load(p, __ATOMIC_RELAXED, __HIP_MEMORY_SCOPE_AGENT); }
DI unsigned xb_add(unsigned* p, unsigned v) { return __hip_atomic_fetch_add(p, v, __ATOMIC_RELAXED, __HIP_MEMORY_SCOPE_AGENT); }
DI unsigned xb_xcc_id() { return (unsigned)__builtin_amdgcn_s_getreg((3 << 11) | 20) & 0xFu; }
#define XB_SPIN(cond, bar) do { unsigned _sp = 0; while (cond) { __builtin_amdgcn_s_sleep(1); \
    if ((++_sp & 255u) == 0u) { if (xb_ld(&(bar)[XB_TMO])) break; if (_sp > XB_SPIN_CAP) { atomicAdd(&(bar)[XB_TMO], 1u); break; } } } } while (0)

struct XcdBarrier { unsigned* bar; unsigned x; volatile LAS unsigned* st; };

DI XcdBarrier xcd_barrier_post(unsigned* bar, volatile LAS unsigned* st) {
    XcdBarrier b; b.bar = bar; b.x = xb_xcc_id(); b.st = st;
    if (threadIdx.x == 0) (void)xb_add(&bar[XB_XCNT(b.x)], 1u);
    return b;
}
DI void xcd_barrier_complete(unsigned* bar, unsigned x, unsigned& nloc, unsigned& nx) {
    const unsigned G = gridDim.x * gridDim.y * gridDim.z;
    unsigned sum, cnt, mine, sp = 0u;
    for (;;) {
        sum = 0u; cnt = 0u; mine = 0u;
#pragma unroll
        for (unsigned j = 0; j < 16; ++j) { const unsigned c = xb_ld(&bar[XB_XCNT(j)]); sum += c; cnt += (c > 0u) ? 1u : 0u; mine = (j == x) ? c : mine; }
        if (sum == G) break;
        __builtin_amdgcn_s_sleep(1);
        if ((++sp & 255u) == 0u) { if (xb_ld(&bar[XB_TMO])) break; if (sp > XB_SPIN_CAP) { atomicAdd(&bar[XB_TMO], 1u); break; } }
    }
    nloc = mine > 0u ? mine : 1u; nx = cnt > 0u ? cnt : 1u;
}
DI void xcd_barrier(const XcdBarrier& b) {
    asm volatile("s_waitcnt vmcnt(0)" ::: "memory");
    __syncthreads();
    if (threadIdx.x == 0) {
        unsigned* bar = b.bar;
        __builtin_amdgcn_s_waitcnt(0);
        unsigned nloc = b.st[0], nx = b.st[1];
        if (nloc == 0u) { xcd_barrier_complete(bar, b.x, nloc, nx); b.st[0] = nloc; b.st[1] = nx; }
        const unsigned old = xb_add(&bar[XB_XSUB(b.x)], 1u);
        const unsigned gen = old / nloc;
        if (old + 1u == (gen + 1u) * nloc) {
            __builtin_amdgcn_fence(__ATOMIC_RELEASE, "agent");
            asm volatile("s_waitcnt vmcnt(0)" ::: "memory");
            const unsigned og = xb_add(&bar[XB_TOP], 1u);
            const unsigned tg = og / nx;
            if (og + 1u == (tg + 1u) * nx) xb_add(&bar[XB_TOPGEN], 1u);
            else XB_SPIN(xb_ld(&bar[XB_TOPGEN]) == tg, bar);
            __builtin_amdgcn_fence(__ATOMIC_ACQUIRE, "agent");
            xb_add(&bar[XB_XGEN(b.x)], 1u);
            asm volatile("s_waitcnt vmcnt(0)" ::: "memory");
        } else {
            XB_SPIN(xb_ld(&bar[XB_XGEN(b.x)]) == gen, bar);
            __builtin_amdgcn_fence(__ATOMIC_ACQUIRE, "agent");
            asm volatile("s_waitcnt vmcnt(0)" ::: "memory");
        }
    }
    __syncthreads();
}

DI void tconv(const float* __restrict__ src, int K, int N, int Npad, u16* __restrict__ dst, const float* __restrict__ g,
              int gtid, int gstride) {
  const int items = Npad * (K >> 3);
  for (int it = gtid; it < items; it += gstride) {
    const int n = it % Npad, kc = it / Npad;
    unsigned w[4];
#pragma unroll
    for (int j = 0; j < 4; ++j) {
      float a = 0.f, b = 0.f;
      if (n < N) {
        a = src[(size_t)(kc * 8 + 2 * j) * N + n]; b = src[(size_t)(kc * 8 + 2 * j + 1) * N + n];
        if (g) { a *= g[kc * 8 + 2 * j]; b *= g[kc * 8 + 2 * j + 1]; }
      }
      w[j] = pk2(a, b);
    }
    *(uint4*)(dst + (size_t)n * K + kc * 8) = make_uint4(w[0], w[1], w[2], w[3]);
  }
}

DI void late_weights(const Params& p, int cb, int ncb, int tid) {
  char* ws = p.ws;
  const int gtid = cb * NTHR + tid, gstride = ncb * NTHR;
  tconv(p.w_uq, 256, 768, 768, (u16*)(ws + OFF_WUQ), p.cq_g, gtid, gstride);
  tconv(p.w_ukv, 128, 1024, 1024, (u16*)(ws + OFF_WUKV), p.ckv_g, gtid, gstride);
  tconv(p.w_out, 1024, 1024, 1024, (u16*)(ws + OFF_WOUT), nullptr, gtid, gstride);
  tconv(p.pwq, 1024, 2048, 2048, (u16*)(ws + OFF_WPQ), p.ffn_g, gtid, gstride);
  for (int i = gtid; i < 16384; i += gstride) {
    ((u16*)(ws + OFF_K1))[i] = f2bf(p.k1[i]);
    ((u16*)(ws + OFF_K2))[i] = f2bf(p.k2[i]);
  }
}
DI void phase0(const Params& p, int bid, int nb, int tid) {
  char* ws = p.ws;
  const int gtid = bid * NTHR + tid, gstride = nb * NTHR;
  tconv(p.w_in, 1024, 2504, DINP, (u16*)(ws + OFF_WIN), nullptr, gtid, gstride);
  const int lane = tid & 63, gw = bid * 8 + (tid >> 6), nw = nb * 8;
  u16* hb = (u16*)(ws + OFF_RA);
  for (int r = gw; r < T_; r += nw) {
    const float4* xr = (const float4*)(p.x + (size_t)r * DM);
    float4 v[4]; float ss = 0.f;
#pragma unroll
    for (int i = 0; i < 4; ++i) { v[i] = xr[lane + 64 * i]; ss += v[i].x * v[i].x + v[i].y * v[i].y + v[i].z * v[i].z + v[i].w * v[i].w; }
    ss = wave_sum(ss);
    const float rstd = rsqrtf(ss * (1.f / 1024.f) + EPS);
#pragma unroll
    for (int i = 0; i < 4; ++i) {
      const float4 g4 = ((const float4*)p.attn_g)[lane + 64 * i];
      *(uint2*)(hb + (size_t)r * DM + 4 * (lane + 64 * i)) = pk4(v[i].x * rstd * g4.x, v[i].y * rstd * g4.y, v[i].z * rstd * g4.z, v[i].w * rstd * g4.w);
    }
  }
}

constexpr int G_BK = 64, G_KS = 2, G_TILE_B = 256 * G_BK * 2, G_STAGE_B = 2 * G_TILE_B, G_GL = G_TILE_B / 8192;
constexpr int LDS_GEMM_OFF = 2048;
DI int lds_byte(int r, int c) {
  int st = (r >> 4) * G_KS + (c >> 5), ob = (r & 15) * 64 + (c & 31) * 2;
  return st * 1024 + (ob ^ (((ob >> 9) & 1) << 5));
}
DI void stage_rc(int b, int& R, int& C) {
  int st = b >> 10, sb = b & 1023, swz = sb ^ (((sb >> 9) & 1) << 5);
  R = (st / G_KS) * 16 + swz / 64;
  C = (st % G_KS) * 32 + (swz % 64) / 2;
}
#define WAIT_V(n) asm volatile("s_waitcnt vmcnt(%0)" ::"n"(n) : "memory")

template <class Epi>
DI void gemm_tile(const u16* __restrict__ A, const u16* __restrict__ Bt, int K, int brow, int bcol, char* smem, int tid, Epi epi) {
  char* shm = smem + LDS_GEMM_OFF;
  const int wid = tid >> 6, lane = tid & 63, wr = wid >> 2, wc = wid & 3, fr = lane & 15, fq = lane >> 4;
  const u16* Ab = A + (size_t)brow * K;
  const u16* Bb = Bt + (size_t)bcol * K;
#define SA(b) (shm + (b) * G_STAGE_B)
#define SB(b) (shm + (b) * G_STAGE_B + G_TILE_B)
  int sR[G_GL], sC[G_GL];
#pragma unroll
  for (int i = 0; i < G_GL; ++i) stage_rc(wid * 1024 + i * 8192 + lane * 16, sR[i], sC[i]);
#define GSRC(base, i, kt) ((base) + (size_t)sR[i] * K + (kt) * G_BK + sC[i])
#define GLDS_STAGE(buf, kt) do { _Pragma("unroll") for (int i = 0; i < G_GL; ++i) { \
      __builtin_amdgcn_global_load_lds((const unsigned*)GSRC(Ab, i, kt), (LAS unsigned*)(SA(buf) + wid * 1024 + i * 8192), 16, 0, 0); \
      __builtin_amdgcn_global_load_lds((const unsigned*)GSRC(Bb, i, kt), (LAS unsigned*)(SB(buf) + wid * 1024 + i * 8192), 16, 0, 0); } } while (0)
  f32x4 acc[8][4];
#pragma unroll
  for (int m = 0; m < 8; ++m)
#pragma unroll
    for (int n = 0; n < 4; ++n) acc[m][n] = (f32x4){0.f, 0.f, 0.f, 0.f};
  const int nt = K / G_BK;
  GLDS_STAGE(0, 0); WAIT_V(0); __syncthreads();
  for (int t = 0; t < nt; ++t) {
    const int cur = t & 1;
    if (t + 1 < nt) GLDS_STAGE(cur ^ 1, t + 1);
#pragma unroll
    for (int ks = 0; ks < G_KS; ++ks) {
      bf16x8 At[8], Bf[4];
#pragma unroll
      for (int m = 0; m < 8; ++m) At[m] = *(const bf16x8*)(SA(cur) + lds_byte(wr * 128 + m * 16 + fr, ks * 32 + fq * 8));
#pragma unroll
      for (int n = 0; n < 4; ++n) Bf[n] = *(const bf16x8*)(SB(cur) + lds_byte(wc * 64 + n * 16 + fr, ks * 32 + fq * 8));
#pragma unroll
      for (int m = 0; m < 8; ++m)
#pragma unroll
        for (int n = 0; n < 4; ++n) acc[m][n] = MFMA16(At[m], Bf[n], acc[m][n]);
      __builtin_amdgcn_sched_barrier(0);
    }
    WAIT_V(0); __syncthreads();
  }
#pragma unroll
  for (int m = 0; m < 8; ++m)
#pragma unroll
    for (int n = 0; n < 4; ++n) epi(m, n, brow + wr * 128 + m * 16 + fq * 4, bcol + wc * 64 + n * 16 + fr, acc[m][n]);
#undef SA
#undef SB
#undef GSRC
#undef GLDS_STAGE
}
constexpr int G8_HALF = 128, G8_HT = G8_HALF * 64;
DI int lds_byte8(int r, int c) {
  int st = (r >> 4) * 2 + (c >> 5), rr = r & 15, cc = c & 31, ob = rr * 64 + cc * 2;
  return st * 1024 + (ob ^ (((ob >> 9) & 1) << 5));
}
DI void stage_rc8(int b, int& R, int& C) {
  int st = b / 1024, sb = b % 1024, swz = sb ^ (((sb >> 9) & 1) << 5);
  R = (st >> 1) * 16 + swz / 64; C = (st & 1) * 32 + (swz % 64) / 2;
}
struct NoPre { DI void operator()(int, int, int, int) const {} };
template <class Epi, class Pre = NoPre>
DI void gemm_tile8(const u16* __restrict__ A, const u16* __restrict__ Bt, int K, int brow, int bcol, char* smem, Epi epi, Pre pre = Pre()) {
  u16* shm = (u16*)(smem + LDS_GEMM_OFF);
#define SA8(b, h) (shm + ((b) * 2 + (h)) * G8_HT)
#define SB8(b, h) (shm + (4 + (b) * 2 + (h)) * G8_HT)
#define STAGE_X8(T, P, BASE, br, kt) do { const unsigned _g = (unsigned)(br) * (unsigned)K + (unsigned)(kt) * 64u; \
    _Pragma("unroll") for (int _i = 0; _i < 2; ++_i) { int _b = (T) * 16 + _i * 8192; int _r, _c; stage_rc8(_b, _r, _c); \
      __builtin_amdgcn_global_load_lds((const unsigned*)((const char*)(BASE) + (size_t)((_g + (unsigned)_r * (unsigned)K + (unsigned)_c) * 2u)), (LAS unsigned*)((char*)(P) + _b), 16, 0, 0); } } while (0)
#define STAGE8(P, BASE, br, kt) STAGE_X8(threadIdx.x, P, BASE, br, kt)
#define LDA8(dst, b, h) _Pragma("unroll") for (int m = 0; m < 4; ++m) _Pragma("unroll") for (int k = 0; k < 2; ++k) \
    dst[m][k] = *reinterpret_cast<const bf16x8*>((char*)SA8(b, h) + lds_byte8(wr * 64 + m * 16 + fr, k * 32 + fq * 8))
#define LDB8(dst, b, h) _Pragma("unroll") for (int n = 0; n < 2; ++n) _Pragma("unroll") for (int k = 0; k < 2; ++k) \
    dst[n][k] = *reinterpret_cast<const bf16x8*>((char*)SB8(b, h) + lds_byte8(wc * 32 + n * 16 + fr, k * 32 + fq * 8))
#define MMA8(ai, bj, At_, Bt_) do { __builtin_amdgcn_s_setprio(1); \
    _Pragma("unroll") for (int m = 0; m < 4; ++m) _Pragma("unroll") for (int n = 0; n < 2; ++n) _Pragma("unroll") for (int k = 0; k < 2; ++k) \
      acc[ai][bj][m][n] = MFMA16(At_[m][k], Bt_[n][k], acc[ai][bj][m][n]); \
    __builtin_amdgcn_s_setprio(0); } while (0)
#define WAIT_V8(n) asm volatile("s_waitcnt vmcnt(" #n ")" ::: "memory")
#define WAIT_L8(n) asm volatile("s_waitcnt lgkmcnt(" #n ")" ::: "memory")
#define BAR8 __builtin_amdgcn_s_barrier()
#define SCHED8 __builtin_amdgcn_sched_barrier(0)
  int wid = threadIdx.x >> 6, lane = threadIdx.x & 63, wr = wid >> 2, wc = wid & 3, fr = lane & 15, fq = lane >> 4;
  f32x4 acc[2][2][4][2];
#pragma unroll
  for (int a = 0; a < 2; ++a)
#pragma unroll
    for (int b = 0; b < 2; ++b)
#pragma unroll
      for (int m = 0; m < 4; ++m)
#pragma unroll
        for (int n = 0; n < 2; ++n) acc[a][b][m][n] = (f32x4){0.f, 0.f, 0.f, 0.f};
  bf16x8 At[4][2], B0[2][2], B1[2][2];
  const int nt = K / 64;
  STAGE8(SB8(0, 0), Bt, bcol, 0); STAGE8(SA8(0, 0), A, brow, 0);
  STAGE8(SB8(0, 1), Bt, bcol + G8_HALF, 0); STAGE8(SA8(0, 1), A, brow + G8_HALF, 0);
  if (wr == 1) BAR8;
  WAIT_V8(4); BAR8;
  STAGE8(SB8(1, 0), Bt, bcol, 1); STAGE8(SA8(1, 0), A, brow, 1); STAGE8(SB8(1, 1), Bt, bcol + G8_HALF, 1);
  WAIT_V8(6); BAR8;
  for (int t = 0; t < nt - 2; t += 2) {
    LDB8(B0, 0, 0); SCHED8; LDA8(At, 0, 0); STAGE8(SA8(1, 1), A, brow + G8_HALF, t + 1);
    WAIT_L8(8); BAR8; WAIT_L8(0); MMA8(0, 0, At, B0); BAR8; SCHED8;
    LDB8(B1, 0, 1); STAGE8(SB8(0, 0), Bt, bcol, t + 2);
    BAR8; WAIT_L8(0); MMA8(0, 1, At, B1); BAR8;
    LDA8(At, 0, 1); STAGE8(SA8(0, 0), A, brow, t + 2);
    BAR8; WAIT_L8(0); MMA8(1, 0, At, B0); BAR8; SCHED8;
    STAGE8(SB8(0, 1), Bt, bcol + G8_HALF, t + 2);
    WAIT_V8(6); BAR8; MMA8(1, 1, At, B1); BAR8;
    LDB8(B0, 1, 0); SCHED8; LDA8(At, 1, 0); STAGE8(SA8(0, 1), A, brow + G8_HALF, t + 2);
    WAIT_L8(8); BAR8; WAIT_L8(0); MMA8(0, 0, At, B0); BAR8; SCHED8;
    LDB8(B1, 1, 1); STAGE8(SB8(1, 0), Bt, bcol, t + 3);
    BAR8; WAIT_L8(0); MMA8(0, 1, At, B1); BAR8;
    LDA8(At, 1, 1); STAGE8(SA8(1, 0), A, brow, t + 3);
    BAR8; WAIT_L8(0); MMA8(1, 0, At, B0); BAR8; SCHED8;
    STAGE8(SB8(1, 1), Bt, bcol + G8_HALF, t + 3);
    WAIT_V8(6); BAR8; MMA8(1, 1, At, B1); BAR8;
  }
  int tz = threadIdx.x; asm volatile("" : "+v"(tz)); wid = tz >> 6; lane = tz & 63; wr = wid >> 2; wc = wid & 3; fr = lane & 15; fq = lane >> 4;
  { LDB8(B0, 0, 0); WAIT_V8(0); LDA8(At, 0, 0); STAGE_X8(tz, SA8(1, 1), A, brow + G8_HALF, nt - 1);
    BAR8; WAIT_L8(0); MMA8(0, 0, At, B0); BAR8;
    LDB8(B1, 0, 1); BAR8; WAIT_L8(0); MMA8(0, 1, At, B1); BAR8;
    LDA8(At, 0, 1); WAIT_V8(4); BAR8; WAIT_L8(0); MMA8(1, 0, At, B0); MMA8(1, 1, At, B1); BAR8; }
  { LDB8(B0, 1, 0); LDA8(At, 1, 0); WAIT_V8(2); BAR8; WAIT_L8(0); MMA8(0, 0, At, B0); BAR8;
    LDB8(B1, 1, 1); WAIT_V8(0); BAR8; WAIT_L8(0); MMA8(0, 1, At, B1); BAR8;
    LDA8(At, 1, 1); BAR8; WAIT_L8(0); MMA8(1, 0, At, B0); MMA8(1, 1, At, B1); BAR8; }
  if (wr == 0) BAR8;
  __syncthreads();
#pragma unroll
  for (int ai = 0; ai < 2; ++ai)
#pragma unroll
    for (int m = 0; m < 4; ++m) {
#pragma unroll
      for (int bj = 0; bj < 2; ++bj)
#pragma unroll
        for (int n = 0; n < 2; ++n)
          pre(ai * 4 + m, bj * 2 + n, brow + ai * G8_HALF + wr * 64 + m * 16 + fq * 4, bcol + bj * G8_HALF + wc * 32 + n * 16 + fr);
#pragma unroll
      for (int bj = 0; bj < 2; ++bj)
#pragma unroll
        for (int n = 0; n < 2; ++n)
          epi(ai * 4 + m, bj * 2 + n, brow + ai * G8_HALF + wr * 64 + m * 16 + fq * 4, bcol + bj * G8_HALF + wc * 32 + n * 16 + fr, acc[ai][bj][m][n]);
    }
  __syncthreads();
#undef SA8
#undef SB8
}
DI int xcd_unit(int u, int nunits) { return (u & 7) * (nunits >> 3) + (u >> 3); }

struct Epi1 {
  char* ws; const float* dummy;
  DI void st16(unsigned off, float v) const { *(u16*)(ws + off) = f2bf(v); }
  DI void operator()(int, int, int r0, int c, f32x4 v) const {
    if (c < 512) {
#pragma unroll
      for (int j = 0; j < 4; ++j) st16((unsigned)OFF_QM + ((unsigned)(r0 + j) * 512u + (unsigned)c) * 2u, v[j]);
    } else if (c < 1024) {
      const int cc = c - 512; const float sc = 0.08838834764831845f;
#pragma unroll
      for (int j = 0; j < 4; ++j) st16((unsigned)OFF_KM + ((unsigned)(r0 + j) * 512u + (unsigned)cc) * 2u, v[j] * sc);
      const int b = r0 >> 12, s = r0 & 4095, hd = cc >> 7, d = cc & 127;
      *(uint2*)(ws + ((unsigned)OFF_KT + ((unsigned)((b * 4 + hd) * 128 + d) * 4096u + (unsigned)s) * 2u)) = pk4(v[0] * sc, v[1] * sc, v[2] * sc, v[3] * sc);
    } else if (c < 1536) {
      const int cc = c - 1024;
      const int b = r0 >> 12, s = r0 & 4095, hd = cc >> 7, d = cc & 127;
      *(uint2*)(ws + ((unsigned)OFF_VT + ((unsigned)((b * 4 + hd) * 128 + d) * 4096u + (unsigned)s) * 2u)) = pk4(v[0], v[1], v[2], v[3]);
    } else if (c < 2048) {
#pragma unroll
      for (int j = 0; j < 4; ++j) st16((unsigned)OFF_OM + ((unsigned)(r0 + j) * 512u + (unsigned)(c - 1536)) * 2u, v[j]);
    } else if (c < 2052) {
#pragma unroll
      for (int j = 0; j < 4; ++j) *(float*)(ws + ((unsigned)OFF_GI + ((unsigned)(r0 + j) * 4u + (unsigned)(c - 2048)) * 4u)) = v[j];
    } else if (c < 2056) {
#pragma unroll
      for (int j = 0; j < 4; ++j) *(float*)(ws + ((unsigned)OFF_GF + ((unsigned)(r0 + j) * 4u + (unsigned)(c - 2052)) * 4u)) = v[j];
    } else if (c < 2504) {
#pragma unroll
      for (int j = 0; j < 4; ++j) st16((unsigned)OFF_LAT + ((unsigned)(r0 + j) * 448u + (unsigned)(c - 2056)) * 2u, v[j]);
    }
  }
};
DI void phase1(const Params& p, int bid, int nb, int tid, char* smem) {
  const int nunits = 64 * 10;
  Epi1 e{p.ws, nullptr};
  for (int u = bid; u < nunits; u += nb) {
    const int v = xcd_unit(u, nunits), pm = v / 10, pn = v % 10;
    gemm_tile8((const u16*)(p.ws + OFF_RA), (const u16*)(p.ws + OFF_WIN), 1024, pm * 256, pn * 256, smem, e);
  }
  const int nfull = nunits % nb;
  if (nfull > 0 && nfull < nb) { if (bid >= nfull) late_weights(p, bid - nfull, nb - nfull, tid); }
  else late_weights(p, bid, nb, tid);
}

DI float logsig(float z) { return fminf(z, 0.f) - log1pf(__expf(-fabsf(z))); }

constexpr int SC_DC = 32 * 136 * 2;
DI void mlstm_scan(const Params& p, int item, char* smem, int tid) {
  asm volatile("" : "+v"(tid));
  char* ws = p.ws;
  const int bh = item >> 2, dq = item & 3;
  const int b = bh >> 2, hd = bh & 3;
  float* s_u = (float*)(smem + 1024);
  float* s_mx = s_u + 4096;
  float* s_bL = s_mx + 64;
  float* s_dec = s_bL + 64;
  float* s_M = s_dec + 64;
  float* s_dn = s_M + 64;
  char* s_dc = (char*)(s_dn + 1024);
  const float* gi = (const float*)(ws + OFF_GI);
  const float* gf = (const float*)(ws + OFF_GF);
  const float bi = p.b_i[hd], bfv = p.b_f[hd];
  const int w = tid >> 6, lane = tid & 63;
  for (int c = w; c < 64; c += 8) {
    const size_t t = (size_t)b * 4096 + c * 64 + lane;
    const float lf = logsig(gf[t * 4 + hd] + bfv), ip = gi[t * 4 + hd] + bi;
    float bc = lf;
#pragma unroll
    for (int o = 1; o < 64; o <<= 1) { const float t2 = __shfl_up(bc, o); if (lane >= o) bc += t2; }
    const float u = ip - bc;
    const float mx = wave_max(u);
    s_u[c * 64 + lane] = u;
    if (lane == 63) { s_bL[c] = bc; s_mx[c] = mx; }
  }
  __syncthreads();
  if (tid == 0) {
    float m = 0.f;
    float* mst = (float*)(ws + OFF_MST) + bh * 64;
    for (int c = 0; c < 64; ++c) {
      const float M63 = fmaxf(m, s_mx[c]);
      s_M[c] = M63; s_dec[c] = __expf(m - M63);
      if (dq == 0) mst[c] = m;
      m = s_bL[c] + M63;
    }
  }
  __syncthreads();
  for (int s = tid; s < 4096; s += NTHR) s_u[s] = __expf(s_u[s] - s_M[s >> 6]);
  __syncthreads();
  const float* s_w = s_u;
  const int r = lane & 31, h = lane >> 5;
  const u16* ka = (const u16*)(ws + OFF_KT) + ((size_t)bh * 128 + r) * 4096 + 8 * h;
  const u16* vb = (const u16*)(ws + OFF_VT) + ((size_t)bh * 128 + 32 * dq + r) * 4096 + 8 * h;
  float Cs[8];
#pragma unroll
  for (int i = 0; i < 8; ++i) Cs[i] = 0.f;
  float ns = 0.f;
  u16* cst = (u16*)(ws + OFF_CST) + (size_t)bh * 64 * 16384 + (size_t)(32 * dq + (tid >> 4)) * 128 + (tid & 15) * 8;
  float* nst = (float*)(ws + OFF_NST) + (size_t)bh * 64 * 128 + tid;
#pragma unroll 1
  for (int j = 0; j < 8; ++j) {
    const int c = 8 * j + w;
    f32x16 D[4];
#pragma unroll
    for (int i = 0; i < 4; ++i) D[i] = zero16();
    float dn[4] = {0.f, 0.f, 0.f, 0.f};
    bf16x8 bv[4];
#pragma unroll
    for (int ks = 0; ks < 4; ++ks) bv[ks] = *(const bf16x8*)(vb + 64 * c + 16 * ks);
#pragma unroll
    for (int ks = 0; ks < 4; ++ks) {
      bf16x8 a[4];
#pragma unroll
      for (int kt = 0; kt < 4; ++kt) a[kt] = *(const bf16x8*)(ka + (size_t)kt * 32 * 4096 + 64 * c + 16 * ks);
      const float4 w0 = *(const float4*)(s_w + c * 64 + 16 * ks + 8 * h), w1 = *(const float4*)(s_w + c * 64 + 16 * ks + 8 * h + 4);
      i32x4 bs;
      bs[0] = (int)pk2(bf2f(bv[ks][0]) * w0.x, bf2f(bv[ks][1]) * w0.y); bs[1] = (int)pk2(bf2f(bv[ks][2]) * w0.z, bf2f(bv[ks][3]) * w0.w);
      bs[2] = (int)pk2(bf2f(bv[ks][4]) * w1.x, bf2f(bv[ks][5]) * w1.y); bs[3] = (int)pk2(bf2f(bv[ks][6]) * w1.z, bf2f(bv[ks][7]) * w1.w);
      const bf16x8 bsv = __builtin_bit_cast(bf16x8, bs);
#pragma unroll
      for (int kt = 0; kt < 4; ++kt) {
        D[kt] = MFMA32(a[kt], bsv, D[kt]);
        if (dq == 0)
          dn[kt] += bf2f(a[kt][0]) * w0.x + bf2f(a[kt][1]) * w0.y + bf2f(a[kt][2]) * w0.z + bf2f(a[kt][3]) * w0.w
                  + bf2f(a[kt][4]) * w1.x + bf2f(a[kt][5]) * w1.y + bf2f(a[kt][6]) * w1.z + bf2f(a[kt][7]) * w1.w;
      }
    }
    char* img = s_dc + w * SC_DC + r * 272 + 8 * h;
#pragma unroll
    for (int kt = 0; kt < 4; ++kt)
#pragma unroll
      for (int g = 0; g < 4; ++g) *(uint2*)(img + (32 * kt + 8 * g) * 2) = pk4(D[kt][4 * g], D[kt][4 * g + 1], D[kt][4 * g + 2], D[kt][4 * g + 3]);
    if (dq == 0) {
#pragma unroll
      for (int kt = 0; kt < 4; ++kt) { const float tn = dn[kt] + __shfl_xor(dn[kt], 32); if (h == 0) s_dn[w * 128 + 32 * kt + r] = tn; }
    }
    __syncthreads();
#pragma unroll
    for (int cc = 0; cc < 8; ++cc) {
      const int cg = 8 * j + cc;
      *(uint4*)(cst + (size_t)cg * 16384) = make_uint4(pk2(Cs[0], Cs[1]), pk2(Cs[2], Cs[3]), pk2(Cs[4], Cs[5]), pk2(Cs[6], Cs[7]));
      const float dec = s_dec[cg];
      const bf16x8 dv = *(const bf16x8*)(s_dc + cc * SC_DC + (tid >> 4) * 272 + (tid & 15) * 16);
#pragma unroll
      for (int i = 0; i < 8; ++i) Cs[i] = Cs[i] * dec + bf2f(dv[i]);
      if (dq == 0 && tid < 128) { nst[(size_t)cg * 128] = ns; ns = ns * dec + s_dn[cc * 128 + tid]; }
    }
    __syncthreads();
  }
}

constexpr int MP_QP = 528, MP_KP = 272;
DI void rope_sc(float posf, int j, float& sv, float& cv) {
  const float invf = exp2f(-(float)j * (13.287712379549449f / 32.f));
  double rev = (double)posf * (double)invf * 0.15915494309189535;
  rev -= __builtin_rint(rev);
  const float fr_ = (float)rev;
  sv = __builtin_amdgcn_sinf(fr_); cv = __builtin_amdgcn_cosf(fr_);
}
DI void mla_prep(const Params& p, int item, char* smem, int tid) {
  asm volatile("" : "+v"(tid));
  char* ws = p.ws;
  char* wl = smem + 1024;
  const int tile = item >> 2, hd = item & 3;
  const int w = tid >> 6, lane = tid & 63, r = lane & 31, h = lane >> 5;
  const int t = tile * 256 + w * 32 + r;
  const int b = t >> 12, s = t & 4095, bh = b * 4 + hd;
  const u16* lat = (const u16*)(ws + OFF_LAT) + (size_t)t * 448;
  const float posf = (float)p.pos[t];
  float* s_qg = (float*)(smem + 1024 + 103424);
  float* s_kg = s_qg + 192;
  const float* q_gp = s_qg; const float* k_gp = s_kg;
  if (tid < 48) ((float4*)s_qg)[tid] = ((const float4*)p.q_g)[tid];
  else if (tid < 96) ((float4*)s_kg)[tid - 48] = ((const float4*)p.k_g)[tid - 48];
  int hro = h; asm volatile("" : "+v"(hro));
  __syncthreads();
  {
    const u16* src = (const u16*)(ws + OFF_WUQ) + (size_t)hd * 192 * 256;
    for (int q = tid; q < 192 * 32; q += NTHR) {
      const int row = q >> 5, ch = q & 31;
      *(i32x4*)(wl + row * MP_QP + ch * 16) = *(const i32x4*)(src + row * 256 + ch * 8);
    }
  }
  bf16x8 bq[6];
#pragma unroll
  for (int ks = 0; ks < 6; ++ks) bq[ks] = *(const bf16x8*)(lat + 16 * ks + 8 * h);
  __syncthreads();
  {
    f32x16 acc[6];
#pragma unroll
    for (int i = 0; i < 6; ++i) acc[i] = zero16();
    float ssq = 0.f;
#pragma unroll
    for (int ks = 0; ks < 16; ++ks) {
      const bf16x8 bcur = bq[ks % 6];
      if (ks + 6 < 16) bq[ks % 6] = *(const bf16x8*)(lat + 16 * (ks + 6) + 8 * h);
#pragma unroll
      for (int j = 0; j < 8; ++j) { const float f = bf2f(bcur[j]); ssq = fmaf(f, f, ssq); }
#pragma unroll
      for (int ft = 0; ft < 6; ++ft) {
        const bf16x8 a = *(const bf16x8*)(wl + (32 * ft + r) * MP_QP + 32 * ks + 16 * h);
        acc[ft] = MFMA32(a, bcur, acc[ft]);
      }
      __builtin_amdgcn_sched_barrier(0);
    }
    ssq += __shfl_xor(ssq, 32);
    const float rstd = rsqrtf(ssq * (1.f / 256.f) + EPS);
    float sq = 0.f;
#pragma unroll
    for (int ft = 0; ft < 6; ++ft)
#pragma unroll
      for (int i = 0; i < 16; ++i) { acc[ft][i] *= rstd; sq = fmaf(acc[ft][i], acc[ft][i], sq); }
    sq += __shfl_xor(sq, 32);
    const float rq = rsqrtf(sq * (1.f / 192.f) + EPS) * (0.07216878364870323f * 1.4426950408889634f);
    int tq = tid; asm volatile("" : "+v"(tq));
    const int t_q = tile * 256 + (tq >> 6) * 32 + (tq & 31), bh_q = (t_q >> 12) * 4 + hd, s_q = t_q & 4095;
    u16* qo = (u16*)(ws + OFF_Q) + ((size_t)bh_q * 4096 + s_q) * 192;
    asm volatile("" ::: "memory");
#pragma unroll
    for (int ft = 0; ft < 4; ++ft)
#pragma unroll
      for (int g = 0; g < 4; ++g) {
        const int f0 = 32 * ft + 8 * g + 4 * h;
        const float4 gg = *(const float4*)(q_gp + f0);
        *(uint2*)(qo + f0) = pk4(acc[ft][4 * g] * rq * gg.x, acc[ft][4 * g + 1] * rq * gg.y, acc[ft][4 * g + 2] * rq * gg.z, acc[ft][4 * g + 3] * rq * gg.w);
      }
    __builtin_amdgcn_sched_barrier(0);
#pragma unroll
    for (int g = 0; g < 4; ++g) {
      const int j0 = 8 * g + 4 * h;
      const float4 g1 = *(const float4*)(q_gp + 128 + j0), g2 = *(const float4*)(q_gp + 160 + j0);
      const float g1a[4] = {g1.x, g1.y, g1.z, g1.w}, g2a[4] = {g2.x, g2.y, g2.z, g2.w};
      float o1[4], o2[4];
#pragma unroll
      for (int q = 0; q < 4; ++q) {
        const float r1 = acc[4][4 * g + q] * rq * g1a[q], r2 = acc[5][4 * g + q] * rq * g2a[q];
        float sv, cv; rope_sc(posf, 8 * g + 4 * hro + q, sv, cv);
        o1[q] = r1 * cv - r2 * sv;
        o2[q] = r1 * sv + r2 * cv;
      }
      *(uint2*)(qo + 128 + j0) = pk4(o1[0], o1[1], o1[2], o1[3]);
      *(uint2*)(qo + 160 + j0) = pk4(o2[0], o2[1], o2[2], o2[3]);
    }
  }
  __syncthreads();
  {
    const u16* src = (const u16*)(ws + OFF_WUKV) + (size_t)hd * 256 * 128;
    for (int q = tid; q < 256 * 16; q += NTHR) {
      const int row = q >> 4, ch = q & 15;
      *(i32x4*)(wl + row * MP_KP + ch * 16) = *(const i32x4*)(src + row * 128 + ch * 8);
    }
  }
  bf16x8 bk[8];
#pragma unroll
  for (int ks = 0; ks < 8; ++ks) bk[ks] = *(const bf16x8*)(lat + 256 + 16 * ks + 8 * h);
  __syncthreads();
  float rstd_kv;
  {
    f32x16 acc[4];
#pragma unroll
    for (int i = 0; i < 4; ++i) acc[i] = zero16();
    float ssq = 0.f;
#pragma unroll
    for (int ks = 0; ks < 8; ++ks) {
#pragma unroll
      for (int j = 0; j < 8; ++j) { const float f = bf2f(bk[ks][j]); ssq = fmaf(f, f, ssq); }
#pragma unroll
      for (int ft = 0; ft < 4; ++ft) {
        const bf16x8 a = *(const bf16x8*)(wl + (32 * ft + r) * MP_KP + 32 * ks + 16 * h);
        acc[ft] = MFMA32(a, bk[ks], acc[ft]);
      }
    }
    ssq += __shfl_xor(ssq, 32);
    rstd_kv = rsqrtf(ssq * (1.f / 128.f) + EPS);
    float kr1[16], kr2[16]; float skr = 0.f;
#pragma unroll
    for (int g = 0; g < 4; ++g) {
      const uint2 a1 = *(const uint2*)(lat + 384 + 8 * g + 4 * h), a2 = *(const uint2*)(lat + 416 + 8 * g + 4 * h);
      kr1[4 * g] = bf2f((short)(a1.x & 0xffff)); kr1[4 * g + 1] = bf2f((short)(a1.x >> 16)); kr1[4 * g + 2] = bf2f((short)(a1.y & 0xffff)); kr1[4 * g + 3] = bf2f((short)(a1.y >> 16));
      kr2[4 * g] = bf2f((short)(a2.x & 0xffff)); kr2[4 * g + 1] = bf2f((short)(a2.x >> 16)); kr2[4 * g + 2] = bf2f((short)(a2.y & 0xffff)); kr2[4 * g + 3] = bf2f((short)(a2.y >> 16));
    }
#pragma unroll
    for (int i = 0; i < 16; ++i) { skr = fmaf(kr1[i], kr1[i], skr); skr = fmaf(kr2[i], kr2[i], skr); }
    float sk = skr;
#pragma unroll
    for (int ft = 0; ft < 4; ++ft)
#pragma unroll
      for (int i = 0; i < 16; ++i) { acc[ft][i] *= rstd_kv; sk = fmaf(acc[ft][i], acc[ft][i], sk); }
    sk += __shfl_xor(sk, 32);
    const float rk = rsqrtf(sk * (1.f / 192.f) + EPS);
    int tq = tid; asm volatile("" : "+v"(tq));
    const int t_q = tile * 256 + (tq >> 6) * 32 + (tq & 31), bh_q = (t_q >> 12) * 4 + hd, s_q = t_q & 4095;
    u16* ko = (u16*)(ws + OFF_K) + ((size_t)bh_q * 4096 + s_q) * 192;
    asm volatile("" ::: "memory");
#pragma unroll
    for (int ft = 0; ft < 4; ++ft)
#pragma unroll
      for (int g = 0; g < 4; ++g) {
        const int f0 = 32 * ft + 8 * g + 4 * h;
        const float4 gg = *(const float4*)(k_gp + f0);
        *(uint2*)(ko + f0) = pk4(acc[ft][4 * g] * rk * gg.x, acc[ft][4 * g + 1] * rk * gg.y, acc[ft][4 * g + 2] * rk * gg.z, acc[ft][4 * g + 3] * rk * gg.w);
      }
    __builtin_amdgcn_sched_barrier(0);
#pragma unroll
    for (int g = 0; g < 4; ++g) {
      const int j0 = 8 * g + 4 * h;
      const float4 g1 = *(const float4*)(k_gp + 128 + j0), g2 = *(const float4*)(k_gp + 160 + j0);
      const float g1a[4] = {g1.x, g1.y, g1.z, g1.w}, g2a[4] = {g2.x, g2.y, g2.z, g2.w};
      float o1[4], o2[4];
#pragma unroll
      for (int q = 0; q < 4; ++q) {
        const float r1 = kr1[4 * g + q] * rk * g1a[q], r2 = kr2[4 * g + q] * rk * g2a[q];
        float sv, cv; rope_sc(posf, 8 * g + 4 * hro + q, sv, cv);
        o1[q] = r1 * cv - r2 * sv;
        o2[q] = r1 * sv + r2 * cv;
      }
      *(uint2*)(ko + 128 + j0) = pk4(o1[0], o1[1], o1[2], o1[3]);
      *(uint2*)(ko + 160 + j0) = pk4(o2[0], o2[1], o2[2], o2[3]);
    }
  }
  {
    f32x16 acc[4];
#pragma unroll
    for (int i = 0; i < 4; ++i) acc[i] = zero16();
#pragma unroll
    for (int ks = 0; ks < 8; ++ks) {
#pragma unroll
      for (int ft = 0; ft < 4; ++ft) {
        const bf16x8 a = *(const bf16x8*)(wl + (128 + 32 * ft + r) * MP_KP + 32 * ks + 16 * h);
        acc[ft] = MFMA32(a, bk[ks], acc[ft]);
      }
    }
    int tq = tid; asm volatile("" : "+v"(tq));
    const int t_q = tile * 256 + (tq >> 6) * 32 + (tq & 31), bh_q = (t_q >> 12) * 4 + hd, s_q = t_q & 4095;
    u16* vo = (u16*)(ws + OFF_VTA) + (size_t)bh_q * 128 * 4096 + s_q + (size_t)(4 * ((tq >> 5) & 1)) * 4096;
#pragma unroll
    for (int vt = 0; vt < 4; ++vt)
#pragma unroll
      for (int g = 0; g < 4; ++g) {
        u16* vp = vo + (size_t)(32 * vt + 8 * g) * 4096;
        asm volatile("" : "+v"(vp));
#pragma unroll
        for (int q = 0; q < 4; ++q) vp[q * 4096] = f2bf(acc[vt][4 * g + q] * rstd_kv);
      }
  }
}

DI float wave_max_pos(float v) {
#define WMX(CTRL, RM) v = fmaxf(v, __int_as_float(__builtin_amdgcn_update_dpp(0, __float_as_int(v), CTRL, RM, 0xF, false)))
  WMX(0xB1, 0xF); WMX(0x4E, 0xF); WMX(0x141, 0xF); WMX(0x140, 0xF); WMX(0x142, 0xA); WMX(0x143, 0xC);
#undef WMX
  return __int_as_float(__builtin_amdgcn_readlane(__float_as_int(v), 63));
}
DI unsigned pack_fp4x4(const float4 c, const float inv) {
  const unsigned p0 = __builtin_amdgcn_cvt_scalef32_pk_fp4_f32(0u, c.x * inv, c.y * inv, 1.0f, 0);
  const unsigned p1 = __builtin_amdgcn_cvt_scalef32_pk_fp4_f32(0u, c.z * inv, c.w * inv, 1.0f, 0);
  return (p0 & 0xFFu) | ((p1 & 0xFFu) << 8);
}
DI void tables_fp8_chunk(const Params& p, int chunk, int tid) {
  asm volatile("" : "+v"(tid));
  char* ws = p.ws;
  const int lane = tid & 63, w = tid >> 6;
  const float4* pu4 = (const float4*)p.pu; const float4* pv4 = (const float4*)p.pv;
  u16* u4 = (u16*)(ws + OFF_U8); u16* v4 = (u16*)(ws + OFF_V8);
  float* rsu = (float*)(ws + OFF_RSU); float* rsv = (float*)(ws + OFF_RSV);
  float4 g[4];
#pragma unroll
  for (int q = 0; q < 4; ++q) g[q] = ((const float4*)p.ffn_g)[lane + 64 * q];
#pragma unroll 1
  for (int r2 = 0; r2 < 4; ++r2) {
    const int row0 = chunk * 64 + w * 8 + r2 * 2;
    float4 a[2][4], c[2][4];
#pragma unroll
    for (int r = 0; r < 2; ++r)
#pragma unroll
      for (int q = 0; q < 4; ++q) { a[r][q] = pu4[(row0 + r) * 256 + lane + 64 * q]; c[r][q] = pv4[(row0 + r) * 256 + lane + 64 * q]; }
#pragma unroll
    for (int r = 0; r < 2; ++r) {
      float mu = 0.f, mv = 0.f;
#pragma unroll
      for (int q = 0; q < 4; ++q) {
        a[r][q].x *= g[q].x; a[r][q].y *= g[q].y; a[r][q].z *= g[q].z; a[r][q].w *= g[q].w;
        mu = fmaxf(fmaxf(fmaxf(mu, fabsf(a[r][q].x)), fabsf(a[r][q].y)), fmaxf(fabsf(a[r][q].z), fabsf(a[r][q].w)));
        mv = fmaxf(fmaxf(fmaxf(mv, fabsf(c[r][q].x)), fabsf(c[r][q].y)), fmaxf(fabsf(c[r][q].z), fabsf(c[r][q].w)));
      }
      mu = wave_max_pos(mu); mv = wave_max_pos(mv);
      const float iu = mu > 0.f ? 6.f / mu : 0.f, iv = mv > 0.f ? 6.f / mv : 0.f;
#pragma unroll
      for (int q = 0; q < 4; ++q) {
        u4[(row0 + r) * 256 + lane + 64 * q] = (u16)pack_fp4x4(a[r][q], iu);
        v4[(row0 + r) * 256 + lane + 64 * q] = (u16)pack_fp4x4(c[r][q], iv);
      }
      if (lane == 0) { rsu[row0 + r] = mu * (1.f / 6.f); rsv[row0 + r] = mv * (1.f / 6.f); }
    }
  }
}
constexpr int Q2_WORD = 3600;
DI void phase2(const Params& p, int bid, int nb, int tid, char* smem, int mode = 3) {
  (void)bid; (void)nb;
  unsigned* qh = (unsigned*)(p.ws + OFF_BAR) + Q2_WORD + 64 * (mode >> 2);
  mode &= 3;
  volatile int* s_item = (volatile int*)(smem + 32);
  for (;;) {
    __syncthreads();
    if (tid == 0) *s_item = (int)__hip_atomic_fetch_add(qh, 1u, __ATOMIC_RELAXED, __HIP_MEMORY_SCOPE_AGENT);
    __syncthreads();
    const int item = *s_item;
    if (item >= 576) break;
    if (item < 64) { if (mode & 1) mlstm_scan(p, item, smem, tid); }
    else if (((item - 64) & 1) == 0) { if (mode & 2) mla_prep(p, (item - 64) >> 1, smem, tid); }
    else { if (mode == 3) tables_fp8_chunk(p, (item - 64) >> 1, tid); }
  }
}

constexpr int A_KP = 400, A_VP = 72, A_KB = 32 * A_KP, A_VB = 128 * A_VP, A_SB = A_KB + A_VB;
DI void attn_qblock(const Params& p, int bh, int qb, char* smem, int tid) {
  char* ws = p.ws;
  char* base = smem + 1024;
  const int w = tid >> 6, lane = tid & 63, r = lane & 31, h = lane >> 5;
  const int rg = w & 3, ksp = w >> 2;
  const int qrow = 128 * qb + 32 * rg + r;
  const u16* Kg = (const u16*)(ws + OFF_K) + (size_t)bh * 4096 * 192;
  const u16* Vg = (const u16*)(ws + OFF_VTA) + (size_t)bh * 128 * 4096;
  bf16x8 qf[12];
  {
    const u16* qp = (const u16*)(ws + OFF_Q) + ((size_t)bh * 4096 + qrow) * 192 + 8 * h;
#pragma unroll
    for (int ks = 0; ks < 12; ++ks) qf[ks] = *(const bf16x8*)(qp + 16 * ks);
  }
  f32x16 O[4];
#pragma unroll
  for (int i = 0; i < 4; ++i) O[i] = zero16();
  float mrun = -1e30f, lrun = 0.f;
  const int nsteps = 2 * (qb + 1);
  const int lastkt = 4 * qb + rg;
  const int krow = tid >> 3, kch = tid & 7;
  const unsigned ksrc0 = (unsigned)((krow * 192 + 8 * kch) * 2);
  const int kdst0 = (krow >> 5) * A_SB + (krow & 31) * A_KP + kch * 16;
  const unsigned vsrc0 = (unsigned)(((tid >> 2) * 4096 + 8 * (tid & 3)) * 2);
  const int vdst0 = A_KB + (tid >> 2) * A_VP + (tid & 3) * 16;
#define A_ISSUEK(KR, step) do { \
      _Pragma("unroll") for (int e = 0; e < 3; ++e) KR[e] = *(const i32x4*)((const char*)Kg + (ksrc0 + (unsigned)((step) * 64 * 192 * 2 + e * 128))); } while (0)
#define A_ISSUEV(VR, step) do { \
      _Pragma("unroll") for (int e = 0; e < 2; ++e) VR[e] = *(const i32x4*)((const char*)Vg + (vsrc0 + (unsigned)((step) * 128 + e * 64))); } while (0)
#define A_WRITEK(KR, st) do { char* sb_ = base + (st) * 2 * A_SB; \
      _Pragma("unroll") for (int e = 0; e < 3; ++e) *(i32x4*)(sb_ + kdst0 + e * 128) = KR[e]; } while (0)
#define A_WRITEV(VR, st) do { char* sb_ = base + (st) * 2 * A_SB; \
      _Pragma("unroll") for (int e = 0; e < 2; ++e) { *(uint2*)(sb_ + vdst0 + e * A_SB) = make_uint2((unsigned)VR[e][0], (unsigned)VR[e][1]); \
        *(uint2*)(sb_ + vdst0 + e * A_SB + 8) = make_uint2((unsigned)VR[e][2], (unsigned)VR[e][3]); } } while (0)
  auto compute = [&](int i, int st) {
    const int kt = 2 * i + ksp;
    if (kt <= lastkt) {
      const char* kb = base + (st * 2 + ksp) * A_SB;
      const char* vbuf = kb + A_KB;
      f32x16 S = zero16();
#pragma unroll
      for (int ks = 0; ks < 12; ++ks) {
        const bf16x8 a = *(const bf16x8*)(kb + r * A_KP + (16 * ks + 8 * h) * 2);
        S = MFMA32(a, qf[ks], S);
      }
      if (kt == lastkt) {
#pragma unroll
        for (int i2 = 0; i2 < 16; ++i2) if (crow(i2, h) > r) S[i2] = -1e30f;
      }
      float mx = S[0];
#pragma unroll
      for (int i2 = 1; i2 < 16; ++i2) mx = fmaxf(mx, S[i2]);
      mx = fmaxf(mx, __shfl_xor(mx, 32));
      const float mnew = fmaxf(mrun, mx);
      float ps = 0.f;
#pragma unroll
      for (int i2 = 0; i2 < 16; ++i2) { S[i2] = __builtin_amdgcn_exp2f(S[i2] - mnew); ps += S[i2]; }
      if (__any(mnew > mrun)) {
        const float alpha = __builtin_amdgcn_exp2f(mrun - mnew);
        lrun *= alpha;
#pragma unroll
        for (int d = 0; d < 4; ++d)
#pragma unroll
          for (int i2 = 0; i2 < 16; ++i2) O[d][i2] *= alpha;
      }
      mrun = mnew;
      lrun += ps;
#pragma unroll
      for (int s2 = 0; s2 < 2; ++s2) {
        i32x4 pw;
#pragma unroll
        for (int j = 0; j < 4; ++j) pw[j] = (int)pk2(S[8 * s2 + 2 * j], S[8 * s2 + 2 * j + 1]);
        const bf16x8 pb = __builtin_bit_cast(bf16x8, pw);
#pragma unroll
        for (int d = 0; d < 4; ++d) {
          const char* va = vbuf + (32 * d + r) * A_VP + (16 * s2 + 4 * h) * 2;
          const uint2 lo = *(const uint2*)va, hi = *(const uint2*)(va + 16);
          i32x4 av = {(int)lo.x, (int)lo.y, (int)hi.x, (int)hi.y};
          O[d] = MFMA32(__builtin_bit_cast(bf16x8, av), pb, O[d]);
        }
      }
    }
  };
  i32x4 kX[3], kY[3], vR[2];
  A_ISSUEK(kX, 0); A_ISSUEV(vR, 0); A_WRITEK(kX, 0); A_WRITEV(vR, 0);
  __syncthreads();
  A_ISSUEK(kX, 1);
  for (int i = 0; i < nsteps; i += 2) {
    if (i + 2 < nsteps) A_ISSUEK(kY, i + 2);
    A_ISSUEV(vR, i + 1);
    compute(i, 0);
    A_WRITEK(kX, 1); A_WRITEV(vR, 1);
    __syncthreads();
    if (i + 3 < nsteps) A_ISSUEK(kX, i + 3);
    if (i + 2 < nsteps) A_ISSUEV(vR, i + 2);
    compute(i + 1, 1);
    if (i + 2 < nsteps) { A_WRITEK(kY, 0); A_WRITEV(vR, 0); }
    __syncthreads();
  }
#undef A_ISSUEK
#undef A_ISSUEV
#undef A_WRITEK
#undef A_WRITEV
  lrun += __shfl_xor(lrun, 32);
  float* cb = (float*)base + (size_t)rg * 66 * 64;
  if (ksp == 1) {
    cb[lane] = mrun; cb[64 + lane] = lrun;
#pragma unroll
    for (int d = 0; d < 4; ++d)
#pragma unroll
      for (int i2 = 0; i2 < 16; ++i2) cb[(2 + d * 16 + i2) * 64 + lane] = O[d][i2];
  }
  __syncthreads();
  if (ksp == 0) {
    const float m1 = cb[lane], l1 = cb[64 + lane];
    const float mt = fmaxf(mrun, m1);
    const float a0 = __builtin_amdgcn_exp2f(mrun - mt), a1 = __builtin_amdgcn_exp2f(m1 - mt);
    const float inv = 1.f / (lrun * a0 + l1 * a1);
    const int hd = bh & 3, b = bh >> 2;
    u16* mo = (u16*)(ws + OFF_MIX) + ((size_t)b * 4096 + qrow) * 1024 + 512 + hd * 128;
#pragma unroll
    for (int d = 0; d < 4; ++d)
#pragma unroll
      for (int g = 0; g < 4; ++g) {
        float o[4];
#pragma unroll
        for (int q = 0; q < 4; ++q) o[q] = (O[d][4 * g + q] * a0 + cb[(2 + d * 16 + 4 * g + q) * 64 + lane] * a1) * inv;
        *(uint2*)(mo + 32 * d + 8 * g + 4 * h) = pk4(o[0], o[1], o[2], o[3]);
      }
  }
  __syncthreads();
}

DI void mlstm_out(const Params& p, int item, char* smem, int tid) {
  asm volatile("" : "+v"(tid));
  char* ws = p.ws;
  const int bh = item >> 6, c = item & 63, b = bh >> 2, hd = bh & 3;
  float* s_b = (float*)(smem + 1024);
  float* s_u = s_b + 64;
  float* s_M = s_u + 64;
  float* s_n = s_M + 64;
  float* s_ss = s_n + 128;
  const float mc = ((const float*)(ws + OFF_MST))[bh * 64 + c];
  const size_t t0 = (size_t)b * 4096 + 64 * c;
  const int w = tid >> 6, lane = tid & 63, r = lane & 31, h = lane >> 5;
  const int tt = w & 1, dt = w >> 1;
  const int tl = 32 * tt + r;
  const size_t tg = t0 + tl;
  const u16* qp = (const u16*)(ws + OFF_QM) + tg * 512 + hd * 128 + 8 * h;
  const u16* kp = (const u16*)(ws + OFF_KM) + (t0 + r) * 512 + hd * 128 + 8 * h;
  const u16* vp = (const u16*)(ws + OFF_VT) + ((size_t)bh * 128 + 32 * dt + r) * 4096 + 64 * c + 4 * h;
  const u16* cp = (const u16*)(ws + OFF_CST) + ((size_t)bh * 64 + c) * 16384 + (size_t)(32 * dt + r) * 128 + 8 * h;
  const u16* op = (const u16*)(ws + OFF_OM) + tg * 512 + hd * 128 + 32 * dt;
  bf16x8 qf[8], kf[2][8], cf[8];
  uint2 vlo[2][2], vhi[2][2], ov[4];
#pragma unroll
  for (int ks = 0; ks < 8; ++ks) qf[ks] = *(const bf16x8*)(qp + 16 * ks);
#pragma unroll
  for (int st = 0; st < 2; ++st)
#pragma unroll
    for (int ks = 0; ks < 8; ++ks) kf[st][ks] = *(const bf16x8*)(kp + (size_t)st * 32 * 512 + 16 * ks);
#pragma unroll
  for (int st = 0; st < 2; ++st)
#pragma unroll
    for (int s2 = 0; s2 < 2; ++s2) { vlo[st][s2] = *(const uint2*)(vp + 32 * st + 16 * s2); vhi[st][s2] = *(const uint2*)(vp + 32 * st + 16 * s2 + 8); }
#pragma unroll
  for (int ks = 0; ks < 8; ++ks) cf[ks] = *(const bf16x8*)(cp + 16 * ks);
#pragma unroll
  for (int g = 0; g < 4; ++g) ov[g] = *(const uint2*)(op + 8 * g + 4 * h);
  if (tid < 64) {
    const float lf = logsig(((const float*)(ws + OFF_GF))[(t0 + tid) * 4 + hd] + p.b_f[hd]);
    const float ip = ((const float*)(ws + OFF_GI))[(t0 + tid) * 4 + hd] + p.b_i[hd];
    float bc = lf;
#pragma unroll
    for (int o = 1; o < 64; o <<= 1) { const float t2 = __shfl_up(bc, o); if (tid >= o) bc += t2; }
    const float u = ip - bc;
    float pm = u;
#pragma unroll
    for (int o = 1; o < 64; o <<= 1) { const float t2 = __shfl_up(pm, o); if (tid >= o) pm = fmaxf(pm, t2); }
    s_b[tid] = bc; s_u[tid] = u; s_M[tid] = fmaxf(mc, pm);
  } else if (tid < 192) {
    s_n[tid - 64] = ((const float*)(ws + OFF_NST))[((size_t)bh * 64 + c) * 128 + (tid - 64)];
  }
  __syncthreads();
  float qn = 0.f;
#pragma unroll
  for (int ks = 0; ks < 8; ++ks)
#pragma unroll
    for (int j = 0; j < 8; ++j) qn = fmaf(bf2f(qf[ks][j]), s_n[16 * ks + 8 * h + j], qn);
  qn += __shfl_xor(qn, 32);
  const float Mt = s_M[tl], bt = s_b[tl];
  const float aw = __expf(mc - Mt);
  f32x16 H1 = zero16(), H2 = zero16();
  float psum = 0.f;
#pragma unroll
  for (int st = 0; st < 2; ++st) {
    f32x16 S = zero16();
#pragma unroll
    for (int ks = 0; ks < 8; ++ks) S = MFMA32(kf[st][ks], qf[ks], S);
#pragma unroll
    for (int i = 0; i < 16; ++i) {
      const int sl = 32 * st + crow(i, h);
      const float wgt = (sl <= tl) ? __expf(s_u[sl] - Mt) : 0.f;
      S[i] *= wgt; psum += S[i];
    }
#pragma unroll
    for (int s2 = 0; s2 < 2; ++s2) {
      i32x4 pw;
#pragma unroll
      for (int j = 0; j < 4; ++j) pw[j] = (int)pk2(S[8 * s2 + 2 * j], S[8 * s2 + 2 * j + 1]);
      i32x4 av = {(int)vlo[st][s2].x, (int)vlo[st][s2].y, (int)vhi[st][s2].x, (int)vhi[st][s2].y};
      H1 = MFMA32(__builtin_bit_cast(bf16x8, av), __builtin_bit_cast(bf16x8, pw), H1);
    }
  }
  psum += __shfl_xor(psum, 32);
#pragma unroll
  for (int ks = 0; ks < 8; ++ks) H2 = MFMA32(cf[ks], qf[ks], H2);
  const float den = aw * qn + psum;
  const float dinv = 1.f / fmaxf(fabsf(den), __expf(-(bt + Mt)));
  float hv[16]; float ss = 0.f;
#pragma unroll
  for (int i = 0; i < 16; ++i) { hv[i] = (H1[i] + aw * H2[i]) * dinv; ss = fmaf(hv[i], hv[i], ss); }
  ss += __shfl_xor(ss, 32);
  if (h == 0) s_ss[dt * 64 + tl] = ss;
  __syncthreads();
  const float tot = s_ss[tl] + s_ss[64 + tl] + s_ss[128 + tl] + s_ss[192 + tl];
  const float rstd = rsqrtf(tot * (1.f / 128.f) + EPS);
  u16* yo = (u16*)(ws + OFF_MIX) + tg * 1024 + hd * 128 + 32 * dt;
  float4 ggv[4];
#pragma unroll
  for (int g = 0; g < 4; ++g) ggv[g] = *(const float4*)(p.mn_g + hd * 128 + 32 * dt + 8 * g + 4 * h);
#pragma unroll
  for (int g = 0; g < 4; ++g) {
    const int d0 = 8 * g + 4 * h;
    const float og[4] = {bf2f((short)(ov[g].x & 0xffff)), bf2f((short)(ov[g].x >> 16)), bf2f((short)(ov[g].y & 0xffff)), bf2f((short)(ov[g].y >> 16))};
    const float4 gg = ggv[g];
    const float ga[4] = {gg.x, gg.y, gg.z, gg.w};
    float y[4];
#pragma unroll
    for (int q = 0; q < 4; ++q) y[q] = hv[4 * g + q] * rstd * ga[q] / (1.f + __expf(-og[q]));
    *(uint2*)(yo + d0) = pk4(y[0], y[1], y[2], y[3]);
  }
  __syncthreads();
}

DI void phase3(const Params& p, int bid, int nb, int tid, char* smem, int mode = 3) {
  if (mode & 1) for (int item = bid; item < 256; item += nb) {
    const int bh = ((item & 7) << 1) | ((item >> 7) & 1), pp = (item >> 3) & 15;
    attn_qblock(p, bh, pp, smem, tid);
    attn_qblock(p, bh, 31 - pp, smem, tid);
  }
  if (mode & 2) for (int item = bid; item < 1024; item += nb) mlstm_out(p, item, smem, tid);
}

DI void phase4(const Params& p, int bid, int nb, int tid, char* smem) {
  char* ws = p.ws;
  const int nunits = 64 * 4;
  for (int u = bid; u < nunits; u += nb) {
    const int v = xcd_unit(u, nunits), pm = v / 4, pn = v % 4;
    float rs[8][4];
    const char* xb = (const char*)p.x;
    float xv[4][4];
    auto pre = [&](int, int ni, int r0, int c) {
#pragma unroll
      for (int j = 0; j < 4; ++j) xv[ni][j] = *(const float*)(xb + ((unsigned)(r0 + j) * 1024u + (unsigned)c) * 4u);
    };
    auto epi = [&](int mi, int ni, int r0, int c, f32x4 a) {
#pragma unroll
      for (int j = 0; j < 4; ++j) {
        const unsigned o = (unsigned)(r0 + j) * 1024u + (unsigned)c;
        const float y = xv[ni][j] + a[j];
        *(u16*)(ws + ((unsigned)OFF_X1B + o * 2u)) = f2bf(y);
        if (ni == 0) rs[mi][j] = y * y; else rs[mi][j] = fmaf(y, y, rs[mi][j]);
      }
    };
    gemm_tile8((const u16*)(ws + OFF_MIX), (const u16*)(ws + OFF_WOUT), 1024, pm * 256, pn * 256, smem, epi, pre);
    int tz = tid; asm volatile("" : "+v"(tz));
    const int wid = tz >> 6, lane = tz & 63, wc = wid & 3, wr = wid >> 2, fr = lane & 15, fq = lane >> 4;
#pragma unroll
    for (int mi = 0; mi < 8; ++mi)
#pragma unroll
      for (int j = 0; j < 4; ++j) {
        float s = rs[mi][j];
        s += __shfl_xor(s, 1); s += __shfl_xor(s, 2); s += __shfl_xor(s, 4); s += __shfl_xor(s, 8);
        if (fr == 0) *(float*)(ws + ((unsigned)OFF_SSQ + ((unsigned)(pm * 256 + (mi >> 2) * 128 + wr * 64 + (mi & 3) * 16 + fq * 4 + j) * 16u + (unsigned)(pn * 4 + wc)) * 4u)) = s;
      }
  }
}

DI void peer_topk_tile(const Params& p, const char* tile, int t0, int hd, int wv, int lane);
DI void phase5(const Params& p, int bid, int nb, int tid, char* smem) {
  char* ws = p.ws;
  const int nunits = 64 * 8;
  float* s_rstd = (float*)(smem + 1024);
  for (int u = bid; u < nunits; u += nb) {
    const int v = xcd_unit(u, nunits), pm = v / 8, pn = v % 8;
    __syncthreads();
    if (tid < 256) {
      const float4* sp = (const float4*)((const float*)(ws + OFF_SSQ) + (size_t)(pm * 256 + tid) * 16);
      float s = 0.f;
#pragma unroll
      for (int i = 0; i < 4; ++i) { const float4 a = sp[i]; s += a.x + a.y + a.z + a.w; }
      s_rstd[tid] = rsqrtf(s * (1.f / 1024.f) + EPS);
    }
    __syncthreads();
    char* tile = smem + LDS_GEMM_OFF;
    auto epi = [&](int, int, int r0, int c, f32x4 a) {
      const int cl = c - pn * 256;
#pragma unroll
      for (int j = 0; j < 4; ++j) {
        const int rl = r0 + j - pm * 256;
        *(u16*)(tile + rl * 512 + ((((cl >> 3) ^ (rl & 31)) << 4) | ((cl & 7) << 1))) = f2bf(a[j] * s_rstd[rl]);
      }
    };
    gemm_tile8((const u16*)(ws + OFF_X1B), (const u16*)(ws + OFF_WPQ), 1024, pm * 256, pn * 256, smem, epi);
    peer_topk_tile(p, tile, pm * 256, pn, __builtin_amdgcn_readfirstlane(tid >> 6), tid & 63);
  }
}

DI void ins16(float (&L)[16], float v) {
#pragma unroll
  for (int j = 15; j >= 1; --j) L[j] = __builtin_amdgcn_fmed3f(L[j - 1], L[j], v);
  L[0] = fmaxf(L[0], v);
}
DI void top16_side(const u16* __restrict__ keys, const u16* __restrict__ qrow, int r, int h, float (&L)[16]) {
  f32x16 acc[4];
#pragma unroll
  for (int i = 0; i < 4; ++i) acc[i] = zero16();
#pragma unroll 2
  for (int ks = 0; ks < 8; ++ks) {
    const bf16x8 bq = *(const bf16x8*)(qrow + 16 * ks + 8 * h);
#pragma unroll
    for (int kt = 0; kt < 4; ++kt) {
      const bf16x8 a = *(const bf16x8*)(keys + (size_t)(32 * kt + r) * 128 + 16 * ks + 8 * h);
      acc[kt] = MFMA32(a, bq, acc[kt]);
    }
  }
#pragma unroll
  for (int j = 0; j < 16; ++j) L[j] = -3.0e38f;
#pragma unroll
  for (int kt = 0; kt < 4; ++kt)
#pragma unroll
    for (int i = 0; i < 16; ++i) {
      const unsigned idx = 32 * kt + crow(i, h);
      const float v = __uint_as_float((__float_as_uint(acc[kt][i]) & ~127u) | idx);
      ins16(L, v);
    }
  float P[16];
#pragma unroll
  for (int j = 0; j < 16; ++j) P[j] = __shfl_xor(L[j], 32);
#pragma unroll
  for (int j = 0; j < 16; ++j) ins16(L, P[j]);
}
#define CE16(i, j) do { const float hi_ = fmaxf(a[i], a[j]), lo_ = fminf(a[i], a[j]); a[i] = hi_; a[j] = lo_; } while (0)
DI void sort16_desc(float (&a)[16]) {
  CE16(0, 1);
  CE16(2, 3);
  CE16(0, 2);
  CE16(1, 3);
  CE16(1, 2);
  CE16(4, 5);
  CE16(6, 7);
  CE16(4, 6);
  CE16(5, 7);
  CE16(5, 6);
  CE16(0, 4);
  CE16(2, 6);
  CE16(2, 4);
  CE16(1, 5);
  CE16(3, 7);
  CE16(3, 5);
  CE16(1, 2);
  CE16(3, 4);
  CE16(5, 6);
  CE16(8, 9);
  CE16(10, 11);
  CE16(8, 10);
  CE16(9, 11);
  CE16(9, 10);
  CE16(12, 13);
  CE16(14, 15);
  CE16(12, 14);
  CE16(13, 15);
  CE16(13, 14);
  CE16(8, 12);
  CE16(10, 14);
  CE16(10, 12);
  CE16(9, 13);
  CE16(11, 15);
  CE16(11, 13);
  CE16(9, 10);
  CE16(11, 12);
  CE16(13, 14);
  CE16(0, 8);
  CE16(4, 12);
  CE16(4, 8);
  CE16(2, 10);
  CE16(6, 14);
  CE16(6, 10);
  CE16(2, 4);
  CE16(6, 8);
  CE16(10, 12);
  CE16(1, 9);
  CE16(5, 13);
  CE16(5, 9);
  CE16(3, 11);
  CE16(7, 15);
  CE16(7, 11);
  CE16(3, 5);
  CE16(7, 9);
  CE16(11, 13);
  CE16(1, 2);
  CE16(3, 4);
  CE16(5, 6);
  CE16(7, 8);
  CE16(9, 10);
  CE16(11, 12);
  CE16(13, 14);
}
DI void merge_top16(float (&a)[16], const float (&b)[16]) {
#pragma unroll
  for (int i = 0; i < 16; ++i) a[i] = fmaxf(a[i], b[15 - i]);
#pragma unroll
  for (int s = 8; s >= 1; s >>= 1)
#pragma unroll
    for (int i = 0; i < 16; ++i)
      if ((i & s) == 0) CE16(i, i + s);
}
DI const bf16x8* qt_chunk(const char* tile, int row, int chunk) { return (const bf16x8*)(tile + row * 512 + ((chunk ^ (row & 31)) << 4)); }
DI void top16_side_lds(const u16* __restrict__ keys_, const char* tile, int row, int side, int r, int h, float (&L)[16]) {
  const char* keys = (const char*)keys_;
  const unsigned koff = ((unsigned)r * 128u + 8u * (unsigned)h) * 2u;
  f32x16 acc[4];
#pragma unroll
  for (int i = 0; i < 4; ++i) acc[i] = zero16();
#pragma unroll 2
  for (int ks = 0; ks < 8; ++ks) {
    const bf16x8 bq = *qt_chunk(tile, row, side * 16 + 2 * ks + h);
#pragma unroll
    for (int kt = 0; kt < 4; ++kt) {
      const bf16x8 a = *(const bf16x8*)(keys + (koff + (unsigned)((32 * kt * 128 + 16 * ks) * 2)));
      acc[kt] = MFMA32(a, bq, acc[kt]);
    }
  }
  float G[4][16];
#pragma unroll
  for (int kt = 0; kt < 4; ++kt) {
#pragma unroll
    for (int i = 0; i < 16; ++i) {
      const unsigned idx = 32 * kt + crow(i, h);
      G[kt][i] = __uint_as_float((__float_as_uint(acc[kt][i]) & ~127u) | idx);
    }
    sort16_desc(G[kt]);
  }
  merge_top16(G[0], G[1]); merge_top16(G[2], G[3]); merge_top16(G[0], G[2]);
  float P[16];
#pragma unroll
  for (int j = 0; j < 16; ++j) P[j] = __shfl_xor(G[0][j], 32);
  merge_top16(G[0], P);
#pragma unroll
  for (int j = 0; j < 16; ++j) L[j] = G[0][j];
}
DI void peer_topk_tile(const Params& p, const char* tile, int t0, int hd, int wv, int lane) {
  asm volatile("" : "+v"(lane));
  char* ws = p.ws;
  const int r = lane & 31, h = lane >> 5;
  const int row = 32 * wv + r, t = t0 + row;
  float L1[16], L2[16];
  top16_side_lds((const u16*)(ws + OFF_K1), tile, row, 0, r, h, L1);
  top16_side_lds((const u16*)(ws + OFF_K2), tile, row, 1, r, h, L2);
  float Lc[16];
#pragma unroll
  for (int j = 0; j < 16; ++j) Lc[j] = -3.0e38f;
#pragma unroll
  for (int i = 0; i < 16; ++i)
#pragma unroll
    for (int j = 0; j < 16; ++j)
      if ((i + 1) * (j + 1) <= 16) ins16(Lc, L1[i] + L2[j]);
  const float th = Lc[15], mx = Lc[0];
  float sum = 0.f;
#pragma unroll
  for (int j = 0; j < 16; ++j) sum += __expf(Lc[j] - mx);
  const float isum = 1.f / sum;
  unsigned* sel = (unsigned*)(ws + OFF_SEL) + (size_t)t * 128 + hd * 16;
  int cnt = 0, pidx = 0;
#pragma unroll
  for (int i = 0; i < 16; ++i)
#pragma unroll
    for (int j = 0; j < 16; ++j)
      if ((i + 1) * (j + 1) <= 16) {
        const float c = L1[i] + L2[j];
        if (c >= th) {
          if (cnt < 16 && ((pidx & 1) == h)) {
            const unsigned idx = (__float_as_uint(L1[i]) & 127u) * 128u + (__float_as_uint(L2[j]) & 127u);
            sel[cnt] = (idx << 18) | ((__float_as_uint(__expf(c - mx) * isum) >> 13) & 0x3FFFFu);
          }
          ++cnt;
        }
        ++pidx;
      }
}
DI void peer_topk(const Params& p, int witem, int lane) {
  char* ws = p.ws;
  const int r = lane & 31, h = lane >> 5;
  const int hd = witem & 7, tb = witem >> 3;
  const int t = tb * 32 + r;
  const u16* qrow = (const u16*)(ws + OFF_QRY) + (size_t)t * 2048 + hd * 256;
  float L1[16], L2[16];
  top16_side((const u16*)(ws + OFF_K1), qrow, r, h, L1);
  top16_side((const u16*)(ws + OFF_K2), qrow + 128, r, h, L2);
  float Lc[16];
#pragma unroll
  for (int j = 0; j < 16; ++j) Lc[j] = -3.0e38f;
#pragma unroll
  for (int i = 0; i < 16; ++i)
#pragma unroll
    for (int j = 0; j < 16; ++j)
      if ((i + 1) * (j + 1) <= 16) ins16(Lc, L1[i] + L2[j]);
  const float th = Lc[15], mx = Lc[0];
  float sum = 0.f;
#pragma unroll
  for (int j = 0; j < 16; ++j) sum += __expf(Lc[j] - mx);
  const float isum = 1.f / sum;
  unsigned* sel = (unsigned*)(ws + OFF_SEL) + (size_t)t * 128 + hd * 16;
  int cnt = 0, pidx = 0;
#pragma unroll
  for (int i = 0; i < 16; ++i)
#pragma unroll
    for (int j = 0; j < 16; ++j)
      if ((i + 1) * (j + 1) <= 16) {
        const float c = L1[i] + L2[j];
        if (c >= th) {
          if (cnt < 16 && ((pidx & 1) == h)) {
            const unsigned idx = (__float_as_uint(L1[i]) & 127u) * 128u + (__float_as_uint(L2[j]) & 127u);
            sel[cnt] = (idx << 18) | ((__float_as_uint(__expf(c - mx) * isum) >> 13) & 0x3FFFFu);
          }
          ++cnt;
        }
        ++pidx;
      }
}
DI void phase6(const Params& p, int bid, int nb, int tid) {
  const int gw = bid * 8 + (tid >> 6), nw = nb * 8;
  for (int wi = gw; wi < 4096; wi += nw) peer_topk(p, wi, tid & 63);
}

template <int CTRL, int RM>
DI float dpp_add(float v) { return v + __int_as_float(__builtin_amdgcn_update_dpp(0, __float_as_int(v), CTRL, RM, 0xF, false)); }
DI float wave_total(float v) {
  v = dpp_add<0xB1, 0xF>(v);
  v = dpp_add<0x4E, 0xF>(v);
  v = dpp_add<0x141, 0xF>(v);
  v = dpp_add<0x140, 0xF>(v);
  v = dpp_add<0x142, 0xA>(v);
  v = dpp_add<0x143, 0xC>(v);
  return __int_as_float(__builtin_amdgcn_readlane(__float_as_int(v), 63));
}
DI void sort128(unsigned& a0, unsigned& a1, int lane) {
#pragma unroll
  for (int k = 2; k <= 128; k <<= 1) {
#pragma unroll
    for (int j = k >> 1; j > 0; j >>= 1) {
      if (j == 64) {
        const unsigned lo = min(a0, a1), hi = max(a0, a1);
        a0 = lo; a1 = hi;
      } else {
        const int pa = (lane ^ j) << 2;
        const unsigned o0 = (unsigned)__builtin_amdgcn_ds_bpermute(pa, (int)a0), o1 = (unsigned)__builtin_amdgcn_ds_bpermute(pa, (int)a1);
        const bool lowpos = (lane & j) == 0;
        const bool asc0 = (k == 128) ? true : ((lane & k) == 0);
        const bool asc1 = (k == 128) ? true : (k == 64 ? false : ((lane & k) == 0));
        a0 = (asc0 == lowpos) ? min(a0, o0) : max(a0, o0);
        a1 = (asc1 == lowpos) ? min(a1, o1) : max(a1, o1);
      }
    }
  }
}
template <int J>
DI unsigned sort_partner(unsigned v, int pa) {
  if (J == 1) return (unsigned)__builtin_amdgcn_update_dpp(0, (int)v, 0xB1, 0xF, 0xF, false);
  if (J == 2) return (unsigned)__builtin_amdgcn_update_dpp(0, (int)v, 0x4E, 0xF, 0xF, false);
  if (J == 8) return (unsigned)__builtin_amdgcn_update_dpp(0, (int)v, 0x128, 0xF, 0xF, false);
  return (unsigned)__builtin_amdgcn_ds_bpermute(pa, (int)v);
}
template <int K, int J>
DI void sort_stage8(unsigned (&a)[8][2], int lane) {
  if (J == 64) {
#pragma unroll
    for (int t = 0; t < 8; ++t) { const unsigned lo = min(a[t][0], a[t][1]), hi = max(a[t][0], a[t][1]); a[t][0] = lo; a[t][1] = hi; }
  } else {
    const int pa = (lane ^ J) << 2;
    unsigned o[8][2];
#pragma unroll
    for (int t = 0; t < 8; ++t) { o[t][0] = sort_partner<J>(a[t][0], pa); o[t][1] = sort_partner<J>(a[t][1], pa); }
    const bool lowpos = (lane & J) == 0;
    const bool asc0 = (K == 128) ? true : ((lane & K) == 0);
    const bool asc1 = (K == 128) ? true : (K == 64 ? false : ((lane & K) == 0));
#pragma unroll
    for (int t = 0; t < 8; ++t) {
      a[t][0] = (asc0 == lowpos) ? min(a[t][0], o[t][0]) : max(a[t][0], o[t][0]);
      a[t][1] = (asc1 == lowpos) ? min(a[t][1], o[t][1]) : max(a[t][1], o[t][1]);
    }
  }
}
template <int K, int J>
DI void sort_merge8(unsigned (&a)[8][2], int lane) { sort_stage8<K, J>(a, lane); if constexpr (J > 1) sort_merge8<K, J / 2>(a, lane); }
template <int K>
DI void sort_all8(unsigned (&a)[8][2], int lane) { if constexpr (K > 2) sort_all8<K / 2>(a, lane); sort_merge8<K, K / 2>(a, lane); }
DI void cvt16(const uint4 r, float (&f)[16]) {
  const unsigned w[4] = {r.x, r.y, r.z, r.w};
#pragma unroll
  for (int i = 0; i < 4; ++i) {
    const f32x2 lo = __builtin_amdgcn_cvt_pk_f32_fp8((int)w[i], false), hi = __builtin_amdgcn_cvt_pk_f32_fp8((int)w[i], true);
    f[4 * i] = lo[0]; f[4 * i + 1] = lo[1]; f[4 * i + 2] = hi[0]; f[4 * i + 3] = hi[1];
  }
}
constexpr int P7_WLDS = 16384;
constexpr int P7_IMG = 2048, P7_DOT = 10752, P7_C8 = 14848, P7_INV = 15872;
DI long lo64v(u32x4 v) { return (long)(((unsigned long long)v[1] << 32) | v[0]); }
DI long hi64v(u32x4 v) { return (long)(((unsigned long long)v[3] << 32) | v[2]); }
DI long lo64(const uint4& v) { return (long)(((unsigned long long)v.y << 32) | v.x); }
DI long hi64(const uint4& v) { return (long)(((unsigned long long)v.w << 32) | v.z); }
#define VW_LOAD(dst, ptr) asm volatile("global_load_dwordx2 %0, %1, off" : "=v"(dst) : "v"(ptr) : "memory")
#define VW_WAIT(n, a, b, c, d) asm volatile("s_waitcnt vmcnt(" #n ")" : "+v"(a), "+v"(b), "+v"(c), "+v"(d) :: "memory")
template <int TPW>
DI void peer_vwalk(const Params& p, int t0, int lane, const unsigned (&pk)[TPW][2], const float (&coef)[TPW][2], bool do_store) {
  static_assert(TPW == 4, "4 tokens per sub-round");
  char* ws = p.ws;
  const unsigned char* V = (const unsigned char*)(ws + OFF_V8) + 8 * lane;
  float y[TPW][16];
#pragma unroll
  for (int k = 0; k < TPW; ++k)
#pragma unroll
    for (int j = 0; j < 16; ++j) y[k][j] = 0.f;
  auto comp = [&](const u32x2& r0, const u32x2& r1, const u32x2& r2, const u32x2& r3, const float (&cf)[4], int pos) {
    const u32x2 rr[4] = {r0, r1, r2, r3};
#pragma unroll
    for (int k = 0; k < 4; ++k) {
      const float c = __int_as_float(__builtin_amdgcn_readlane(__float_as_int(cf[k]), pos));
#pragma unroll
      for (int i = 0; i < 2; ++i) {
        const f32x2 e0 = __builtin_amdgcn_cvt_scalef32_pk_f32_fp4(rr[k][i], 1.0f, 0), e1 = __builtin_amdgcn_cvt_scalef32_pk_f32_fp4(rr[k][i], 1.0f, 1);
        const f32x2 e2 = __builtin_amdgcn_cvt_scalef32_pk_f32_fp4(rr[k][i], 1.0f, 2), e3 = __builtin_amdgcn_cvt_scalef32_pk_f32_fp4(rr[k][i], 1.0f, 3);
        y[k][8 * i] = fmaf(c, e0[0], y[k][8 * i]); y[k][8 * i + 1] = fmaf(c, e0[1], y[k][8 * i + 1]);
        y[k][8 * i + 2] = fmaf(c, e1[0], y[k][8 * i + 2]); y[k][8 * i + 3] = fmaf(c, e1[1], y[k][8 * i + 3]);
        y[k][8 * i + 4] = fmaf(c, e2[0], y[k][8 * i + 4]); y[k][8 * i + 5] = fmaf(c, e2[1], y[k][8 * i + 5]);
        y[k][8 * i + 6] = fmaf(c, e3[0], y[k][8 * i + 6]); y[k][8 * i + 7] = fmaf(c, e3[1], y[k][8 * i + 7]);
      }
    }
  };
#define VW_ROWP(arr, k, pos) (V + (size_t)(((unsigned)__builtin_amdgcn_readlane((int)arr[k], pos)) >> 18) * 512)
#define VW_LOAD4(x0, x1, x2, x3, arr, pos) do { VW_LOAD(x0, VW_ROWP(arr, 0, pos)); VW_LOAD(x1, VW_ROWP(arr, 1, pos)); VW_LOAD(x2, VW_ROWP(arr, 2, pos)); VW_LOAD(x3, VW_ROWP(arr, 3, pos)); } while (0)
  u32x2 a0, a1, a2, a3, b0, b1, b2, b3, c0, c1, c2, c3, d0, d1, d2, d3, e0, e1, e2, e3, f0, f1, f2, f3, g0, g1, g2, g3, h0, h1, h2, h3;
  {
    unsigned pk0[4];
#pragma unroll
    for (int k = 0; k < 4; ++k) pk0[k] = pk[k][0];
    VW_LOAD4(a0, a1, a2, a3, pk0, 0); VW_LOAD4(b0, b1, b2, b3, pk0, 1); VW_LOAD4(c0, c1, c2, c3, pk0, 2); VW_LOAD4(d0, d1, d2, d3, pk0, 3); VW_LOAD4(e0, e1, e2, e3, pk0, 4); VW_LOAD4(f0, f1, f2, f3, pk0, 5); VW_LOAD4(g0, g1, g2, g3, pk0, 6);
  }
#pragma unroll 1
  for (int it = 0; it < 128; it += 8) {
    const bool hi_c = (it & 64) != 0, hi_n = ((it + 8) & 64) != 0;
    const int pc = it & 63, pn = (it + 8) & 63;
    unsigned pkc[4], pkn[4]; float cfc[4];
#pragma unroll
    for (int k = 0; k < 4; ++k) { pkc[k] = hi_c ? pk[k][1] : pk[k][0]; pkn[k] = hi_n ? pk[k][1] : pk[k][0]; cfc[k] = hi_c ? coef[k][1] : coef[k][0]; }
    VW_LOAD4(h0, h1, h2, h3, pkc, pc + 7); VW_WAIT(28, a0, a1, a2, a3); comp(a0, a1, a2, a3, cfc, pc + 0);
    VW_LOAD4(a0, a1, a2, a3, pkn, pn + 0); VW_WAIT(28, b0, b1, b2, b3); comp(b0, b1, b2, b3, cfc, pc + 1);
    VW_LOAD4(b0, b1, b2, b3, pkn, pn + 1); VW_WAIT(28, c0, c1, c2, c3); comp(c0, c1, c2, c3, cfc, pc + 2);
    VW_LOAD4(c0, c1, c2, c3, pkn, pn + 2); VW_WAIT(28, d0, d1, d2, d3); comp(d0, d1, d2, d3, cfc, pc + 3);
    VW_LOAD4(d0, d1, d2, d3, pkn, pn + 3); VW_WAIT(28, e0, e1, e2, e3); comp(e0, e1, e2, e3, cfc, pc + 4);
    VW_LOAD4(e0, e1, e2, e3, pkn, pn + 4); VW_WAIT(28, f0, f1, f2, f3); comp(f0, f1, f2, f3, cfc, pc + 5);
    VW_LOAD4(f0, f1, f2, f3, pkn, pn + 5); VW_WAIT(28, g0, g1, g2, g3); comp(g0, g1, g2, g3, cfc, pc + 6);
    VW_LOAD4(g0, g1, g2, g3, pkn, pn + 6); VW_WAIT(28, h0, h1, h2, h3); comp(h0, h1, h2, h3, cfc, pc + 7);
  }
  asm volatile("s_waitcnt vmcnt(0)" : "+v"(a0), "+v"(a1), "+v"(a2), "+v"(a3), "+v"(b0), "+v"(b1), "+v"(b2), "+v"(b3), "+v"(c0), "+v"(c1), "+v"(c2), "+v"(c3), "+v"(d0), "+v"(d1), "+v"(d2), "+v"(d3), "+v"(e0), "+v"(e1), "+v"(e2), "+v"(e3), "+v"(f0), "+v"(f1), "+v"(f2), "+v"(f3), "+v"(g0), "+v"(g1), "+v"(g2), "+v"(g3) :: "memory");
#undef VW_LOAD4
#undef VW_ROWP
  float* dst = do_store ? p.out : (float*)(ws + OFF_QRY);
#pragma unroll
  for (int k = 0; k < TPW; ++k) {
    const float4* o = (const float4*)(p.out + (size_t)(t0 + k) * DM + 16 * lane);
    float4* w = (float4*)(dst + (size_t)(t0 + k) * DM + 16 * lane);
    float4 a[4];
#pragma unroll
    for (int q = 0; q < 4; ++q) a[q] = o[q];
#pragma unroll
    for (int q = 0; q < 4; ++q) {
      a[q].x += y[k][4 * q]; a[q].y += y[k][4 * q + 1]; a[q].z += y[k][4 * q + 2]; a[q].w += y[k][4 * q + 3];
      w[q] = a[q];
    }
  }
}
DI void peer_vwalk_mfma(const Params& p, int t0, int lane, char* wl, bool do_store) {
  char* ws = p.ws;
  const unsigned char* V = (const unsigned char*)(ws + OFF_V8);
  const u16* s_list = (const u16*)wl;
  char* s_img = wl + P7_IMG;
  const unsigned char* s_c8 = (const unsigned char*)(wl + P7_C8);
  const float* s_inv = (const float*)(wl + P7_INV);
  const int b = lane >> 4, n = lane & 15, lr = lane >> 3, lc = lane & 7;
  const bool a_act = ((b & 1) == 0) && (n < 8);
  const int sh = 8 * (n & 3);
  const bool lo4 = n < 4;
  float* dst = do_store ? p.out : (float*)(ws + OFF_QRY);
  f32x4 acc[16];
#pragma unroll
  for (int nt = 0; nt < 16; ++nt) acc[nt] = (f32x4){0.f, 0.f, 0.f, 0.f};
  auto gload = [&](u32x4 (&R)[8], int rr) {
    const int qd = rr >> 4, r = rr & 15;
    const u32x4 ids = *(const u32x4*)(s_list + lr * 128 + 8 * r);
#pragma unroll
    for (int i = 0; i < 8; ++i) {
      const unsigned idx = (ids[i >> 1] >> (16 * (i & 1))) & 0xFFFFu;
      R[i] = *(const u32x4*)(V + (size_t)idx * 512 + 128 * qd + 16 * lc);
    }
  };
  auto stage = [&](const u32x4 (&R)[8]) {
#pragma unroll
    for (int i = 0; i < 8; ++i) {
      char* d = s_img + (8 * i + lr) * 136 + 16 * lc;
      *(u32x2*)d = (u32x2){R[i][0], R[i][1]};
      *(u32x2*)(d + 8) = (u32x2){R[i][2], R[i][3]};
    }
  };
  auto round = [&](int r) {
    const u32x2 cw = *(const u32x2*)(s_c8 + (n & 7) * 128 + 8 * r);
    const unsigned x = cw[0] >> (8 * b), y = cw[1] >> (8 * b);
    const unsigned c0 = a_act ? ((x & 0xFFu) << sh) : 0u, c1 = a_act ? (((x >> 8) & 0xFFu) << sh) : 0u;
    const unsigned c2 = a_act ? ((y & 0xFFu) << sh) : 0u, c3 = a_act ? (((y >> 8) & 0xFFu) << sh) : 0u;
    const i32x8 A = {(int)(lo4 ? c0 : 0u), (int)(lo4 ? 0u : c0), (int)(lo4 ? c1 : 0u), (int)(lo4 ? 0u : c1),
                     (int)(lo4 ? c2 : 0u), (int)(lo4 ? 0u : c2), (int)(lo4 ? c3 : 0u), (int)(lo4 ? 0u : c3)};
#pragma unroll
    for (int nt = 0; nt < 16; ++nt) {
      const i32x2 bb = __builtin_amdgcn_ds_read_tr4_b64_v2i32((i32x2 LAS*)(s_img + (16 * b + n) * 136 + 8 * nt));
      const i32x8 B = {bb[0], bb[1], bb[0], bb[1], 0, 0, 0, 0};
      acc[nt] = __builtin_amdgcn_mfma_scale_f32_16x16x128_f8f6f4(A, B, acc[nt], 0, 4, 0, 0, 0, 0);
    }
  };
  auto flush = [&](int qd) {
    if (b < 2) {
      float inv[4];
#pragma unroll
      for (int i = 0; i < 4; ++i) inv[i] = s_inv[4 * b + i];
#pragma unroll
      for (int n4 = 0; n4 < 16; n4 += 4) {
        float o[4][4];
#pragma unroll
        for (int q = 0; q < 4; ++q)
#pragma unroll
          for (int i = 0; i < 4; ++i) o[q][i] = bf2f(((const u16*)(ws + OFF_X1B))[(size_t)(t0 + 4 * b + i) * DM + 256 * qd + 16 * (n4 + q) + n]);
#pragma unroll
        for (int q = 0; q < 4; ++q)
#pragma unroll
          for (int i = 0; i < 4; ++i) dst[(size_t)(t0 + 4 * b + i) * DM + 256 * qd + 16 * (n4 + q) + n] = fmaf(acc[n4 + q][i], inv[i], o[q][i]);
      }
    }
#pragma unroll
    for (int nt = 0; nt < 16; ++nt) acc[nt] = (f32x4){0.f, 0.f, 0.f, 0.f};
  };
  u32x4 rA[8], rB[8];
  gload(rA, 0); gload(rB, 1);
#pragma unroll 1
  for (int rr = 0; rr < 64; rr += 2) {
    stage(rA);
    gload(rA, (rr + 2 < 64) ? rr + 2 : 0);
    round(rr & 15);
    stage(rB);
    gload(rB, (rr + 3 < 64) ? rr + 3 : 1);
    round((rr + 1) & 15);
    if ((rr & 15) == 14) flush(rr >> 4);
  }
}
DI void peer_gather8(const Params& p, int t0, int lane, char* wl, bool do_store, int mode = 3) {
  asm volatile("v_mbcnt_lo_u32_b32 %0, -1, 0\n\tv_mbcnt_hi_u32_b32 %0, -1, %0" : "=v"(lane));
  char* ws = p.ws;
  const unsigned char* U = (const unsigned char*)(ws + OFF_U8);
  u16* s_list = (u16*)wl;
  unsigned char* s_x = (unsigned char*)(wl + 2048);
  float* s_dot = (float*)(wl + P7_DOT);
  unsigned pk[8][2];
  {
    bf16x8 xa[8], xb[8]; float sp[8];
#pragma unroll
    for (int k = 0; k < 8; ++k) {
      const int t = t0 + k;
      const unsigned* sel = (const unsigned*)(ws + OFF_SEL) + (size_t)t * 128;
      pk[k][0] = sel[lane]; pk[k][1] = sel[64 + lane];
      const u16* xr = (const u16*)(ws + OFF_X1B) + (size_t)t * DM + 16 * lane;
      xa[k] = *(const bf16x8*)xr; xb[k] = *(const bf16x8*)(xr + 8);
      sp[k] = (lane < 16) ? ((const float*)(ws + OFF_SSQ))[(size_t)t * 16 + lane] : 0.f;
    }
    __builtin_amdgcn_sched_barrier(0);
    sort_all8<128>(pk, lane);
#pragma unroll
    for (int k = 0; k < 8; ++k) {
      s_list[k * 128 + lane] = (u16)(pk[k][0] >> 18); s_list[k * 128 + 64 + lane] = (u16)(pk[k][1] >> 18);
      const float sc = rsqrtf(wave_total(sp[k]) * (1.f / 1024.f) + EPS) * 16.f;
      const bf16x8 xa_ = xa[k], xb_ = xb[k];
      int w0 = __builtin_amdgcn_cvt_pk_fp8_f32(bf2f(xa_[0]) * sc, bf2f(xa_[1]) * sc, 0, false); w0 = __builtin_amdgcn_cvt_pk_fp8_f32(bf2f(xa_[2]) * sc, bf2f(xa_[3]) * sc, w0, true);
      int w1 = __builtin_amdgcn_cvt_pk_fp8_f32(bf2f(xa_[4]) * sc, bf2f(xa_[5]) * sc, 0, false); w1 = __builtin_amdgcn_cvt_pk_fp8_f32(bf2f(xa_[6]) * sc, bf2f(xa_[7]) * sc, w1, true);
      int w2 = __builtin_amdgcn_cvt_pk_fp8_f32(bf2f(xb_[0]) * sc, bf2f(xb_[1]) * sc, 0, false); w2 = __builtin_amdgcn_cvt_pk_fp8_f32(bf2f(xb_[2]) * sc, bf2f(xb_[3]) * sc, w2, true);
      int w3 = __builtin_amdgcn_cvt_pk_fp8_f32(bf2f(xb_[4]) * sc, bf2f(xb_[5]) * sc, 0, false); w3 = __builtin_amdgcn_cvt_pk_fp8_f32(bf2f(xb_[6]) * sc, bf2f(xb_[7]) * sc, w3, true);
      *(uint4*)(s_x + k * 1024 + 16 * lane) = make_uint4((unsigned)w0, (unsigned)w1, (unsigned)w2, (unsigned)w3);
    }
  }
  asm volatile("s_waitcnt lgkmcnt(0)" ::: "memory");
  if (mode & 1) {
    const int g = lane >> 4, jc = lane & 15, tok = lane & 7, uu = (lane >> 3) & 1;
    i32x8 xfr[8];
#pragma unroll
    for (int c = 0; c < 8; ++c) {
      const int o0 = 256 * (g >> 1) + 32 * c + 16 * (g & 1);
      const i32x4 x0 = *(const i32x4*)(s_x + tok * 1024 + o0), x1 = *(const i32x4*)(s_x + tok * 1024 + o0 + 512);
      xfr[c] = __builtin_shufflevector(x0, x1, 0, 1, 2, 3, 4, 5, 6, 7);
    }
    asm volatile("s_waitcnt lgkmcnt(0)" ::: "memory");
    const bool keep = (g == ((lane >> 2) & 1));
    char* s_stage = (char*)s_x;
    const int jl = lane >> 5, cl = lane & 31, gl = cl >> 3, cpl = cl & 7;
    auto gload = [&](u32x4 (&R)[8], int step) {
#pragma unroll
      for (int i = 0; i < 8; ++i) {
        const int j = 2 * i + jl;
        const unsigned idx = s_list[(j & 7) * 128 + 2 * step + (j >> 3)];
        R[i] = *(const u32x4*)(U + (size_t)idx * 512 + 16 * cl);
      }
    };
    auto stage = [&](const u32x4 (&R)[8]) {
#pragma unroll
      for (int i = 0; i < 8; ++i) {
        const int j = 2 * i + jl;
        *(u32x4*)(s_stage + gl * 2048 + j * 128 + ((cpl + (j >> 1)) & 7) * 16) = R[i];
      }
    };
    f32x4 acc = {0.f, 0.f, 0.f, 0.f};
#define P7_COMP() do { _Pragma("unroll") for (int c = 0; c < 8; ++c) { \
        const i32x4 b = *(const i32x4*)(s_stage + g * 2048 + jc * 128 + ((c + (jc >> 1)) & 7) * 16); \
        const i32x8 b8 = {b[0], b[1], b[2], b[3], 0, 0, 0, 0}; \
        acc = __builtin_amdgcn_mfma_scale_f32_16x16x128_f8f6f4(xfr[c], b8, acc, 0, 4, 0, 0, 0, 0); } } while (0)
#define P7_KEEP(ST) do { const int sel2 = lane & 3; \
      const float v = sel2 == 0 ? acc[0] : sel2 == 1 ? acc[1] : sel2 == 2 ? acc[2] : acc[3]; \
      if (keep) s_dot[tok * 128 + 2 * (ST) + uu] = v; \
      acc = (f32x4){0.f, 0.f, 0.f, 0.f}; } while (0)
    u32x4 rA[8], rB[8];
    gload(rA, 0); gload(rB, 1);
#pragma unroll 1
    for (int st = 0; st < 64; st += 2) {
      stage(rA);
      gload(rA, (st + 2 < 64) ? st + 2 : 0);
      P7_COMP();
      P7_KEEP(st);
      stage(rB);
      gload(rB, (st + 3 < 64) ? st + 3 : 1);
      P7_COMP();
      P7_KEEP(st + 1);
    }
  }
  asm volatile("s_waitcnt lgkmcnt(0)" ::: "memory");
  {
    unsigned char* s_c8 = (unsigned char*)(wl + P7_C8);
    float* s_inv = (float*)(wl + P7_INV);
#pragma unroll
    for (int k = 0; k < 8; ++k) {
      float cf[2];
#pragma unroll
      for (int rg = 0; rg < 2; ++rg) {
        const float d = s_dot[k * 128 + 64 * rg + lane] * (((const float*)(ws + OFF_RSU))[pk[k][rg] >> 18] * (1.f / 16.f));
        const float act = 0.5f * d * (1.f + erff(d * 0.7071067811865476f));
        const float gate = __uint_as_float((pk[k][rg] & 0x3FFFFu) << 13);
        cf[rg] = gate * act * ((const float*)(ws + OFF_RSV))[pk[k][rg] >> 18];
      }
      const float m = wave_max_pos(fmaxf(fabsf(cf[0]), fabsf(cf[1])));
      const float S = m > 0.f ? 384.f / m : 0.f;
#pragma unroll
      for (int rg = 0; rg < 2; ++rg)
        s_c8[k * 128 + 64 * rg + lane] = (unsigned char)(__builtin_amdgcn_cvt_pk_fp8_f32(cf[rg] * S, 0.f, 0, false) & 0xFF);
      if (lane == 0) s_inv[k] = m * (1.f / 384.f);
    }
  }
  asm volatile("s_waitcnt lgkmcnt(0)" ::: "memory");
  if (mode & 2) peer_vwalk_mfma(p, t0, lane, wl, do_store);
}
DI void phase7(const Params& p, int bid, int nb, int tid, char* smem, bool do_store, int mode = 3) {
  const int lane = tid & 63, w = __builtin_amdgcn_readfirstlane(tid >> 6), gw = bid * 8 + w, nw = nb * 8;
  char* wl = smem + 1024 + w * P7_WLDS;
  for (int g = gw; g < T_ / 8; g += nw) peer_gather8(p, g * 8, lane, wl, do_store, mode);
}

#ifndef PROBE_MODE2
#define PROBE_MODE2 3
#endif
#ifndef ONLYP
#define ONLYP -1
#endif
#ifndef PROBE_REP
#define PROBE_REP 0
#endif
#ifndef REP_PHASE
#define REP_PHASE -1
#endif
constexpr int LDS_BYTES = LDS_GEMM_OFF + 2 * G_STAGE_B;

DI Params phase_params() {
  const char* ka = (const char*)__builtin_amdgcn_kernarg_segment_ptr();
  asm volatile("" : "+s"(ka));
  return *(const Params*)ka;
}
__global__ void __launch_bounds__(NTHR, 2) mega(Params p, int ph_lo, int ph_hi, int rep) {
  __shared__ __attribute__((aligned(16))) char smem[LDS_BYTES];
  const int tid = threadIdx.x, bid = blockIdx.x, nb = gridDim.x;
  if (tid == 0) *(uint4*)smem = make_uint4(0u, 0u, 0u, 0u);
  __syncthreads();
  XcdBarrier bar;
  const bool multi = ph_hi > ph_lo;
  if (multi) bar = xcd_barrier_post((unsigned*)(p.ws + OFF_BAR), (volatile LAS unsigned*)smem);
  if ((ONLYP < 0 || ONLYP == 0) && ph_lo <= 0 && 0 <= ph_hi) { if (PROBE_REP && REP_PHASE == 0) { phase0(p, bid, nb, tid); __syncthreads(); } phase0(p, bid, nb, tid); if (ph_hi > 0) xcd_barrier(bar); }
  if ((ONLYP < 0 || ONLYP == 1) && ph_lo <= 1 && 1 <= ph_hi) { if (PROBE_REP && REP_PHASE == 1) { phase1(p, bid, nb, tid, smem); __syncthreads(); } phase1(p, bid, nb, tid, smem); if (ph_hi > 1) xcd_barrier(bar); }
  if ((ONLYP < 0 || ONLYP == 2) && ph_lo <= 2 && 2 <= ph_hi) { if (PROBE_REP && REP_PHASE == 2) { phase2(p, bid, nb, tid, smem, PROBE_MODE2 | 4); __syncthreads(); } phase2(p, bid, nb, tid, smem); if (ph_hi > 2) xcd_barrier(bar); }
  if ((ONLYP < 0 || ONLYP == 3) && ph_lo <= 3 && 3 <= ph_hi) { if (PROBE_REP && REP_PHASE == 3) { phase3(p, bid, nb, tid, smem, PROBE_MODE2); __syncthreads(); } phase3(p, bid, nb, tid, smem); if (ph_hi > 3) xcd_barrier(bar); }
  if ((ONLYP < 0 || ONLYP == 4) && ph_lo <= 4 && 4 <= ph_hi) { if (PROBE_REP && REP_PHASE == 4) { phase4(p, bid, nb, tid, smem); __syncthreads(); } phase4(p, bid, nb, tid, smem); if (ph_hi > 4) xcd_barrier(bar); }
  if ((ONLYP < 0 || ONLYP == 5) && ph_lo <= 5 && 5 <= ph_hi) { if (PROBE_REP && REP_PHASE == 5) { phase5(p, bid, nb, tid, smem); __syncthreads(); } phase5(p, bid, nb, tid, smem); if (ph_hi > 5) xcd_barrier(bar); }
  if ((ONLYP < 0 || ONLYP == 7) && ph_lo <= 7 && 7 <= ph_hi) { if (PROBE_REP && REP_PHASE == 7) phase7(p, bid, nb, tid, smem, ph_hi < 0, PROBE_MODE2); phase7(p, bid, nb, tid, smem, true); }
}

#ifndef ONLYP
#define ONLYP -1
#endif
#ifndef PROBE_REP
#define PROBE_REP 0
#endif
#ifndef REP_PHASE
#define REP_PHASE -1
#endif
#ifndef MK_LAUNCHES
#define MK_LAUNCHES 1
#endif

extern "C" void kernel_launch(void* const* d_in, const int* in_sizes, int n_in, void* d_out, int out_size, void* d_ws, size_t ws_size,
                              hipStream_t stream) {
  (void)in_sizes; (void)n_in; (void)out_size; (void)ws_size;
  static int grid = 0;
  if (!grid) {
    int dev = 0, cus = 0;
    (void)hipGetDevice(&dev);
    (void)hipDeviceGetAttribute(&cus, hipDeviceAttributeMultiprocessorCount, dev);
    int per_cu = 0;
    (void)hipOccupancyMaxActiveBlocksPerMultiprocessor(&per_cu, (const void*)mega, NTHR, 0);
    if (per_cu < 1) per_cu = 1;
    grid = cus > 0 ? cus : 256;
  }
  Params p{};
  p.x = (const float*)d_in[0]; p.pos = (const int*)d_in[1]; p.attn_g = (const float*)d_in[2]; p.w_in = (const float*)d_in[3];
  p.b_i = (const float*)d_in[4]; p.b_f = (const float*)d_in[5]; p.mn_g = (const float*)d_in[6]; p.cq_g = (const float*)d_in[7];
  p.w_uq = (const float*)d_in[8]; p.ckv_g = (const float*)d_in[9]; p.w_ukv = (const float*)d_in[10]; p.q_g = (const float*)d_in[11];
  p.k_g = (const float*)d_in[12]; p.w_out = (const float*)d_in[13]; p.ffn_g = (const float*)d_in[14]; p.pwq = (const float*)d_in[15];
  p.k1 = (const float*)d_in[16]; p.k2 = (const float*)d_in[17]; p.pu = (const float*)d_in[18]; p.pv = (const float*)d_in[19];
  p.out = (float*)d_out; p.ws = (char*)d_ws;
  (void)hipMemsetAsync(d_ws, 0, 16384, stream);
#if MK_LAUNCHES == 1
  hipLaunchKernelGGL(mega, dim3(grid), dim3(NTHR), 0, stream, p, 0, 7, REP_PHASE);
#else
  for (int ph = 0; ph < 8; ++ph) hipLaunchKernelGGL(mega, dim3(grid), dim3(NTHR), 0, stream, p, ph, ph, REP_PHASE);
#endif
}
```

```cpp
#include <hip/hip_runtime.h>
#include <stdint.h>

#define DI __device__ __forceinline__
typedef __attribute__((ext_vector_type(8))) short bf16x8;
typedef __attribute__((ext_vector_type(4))) float f32x4;
typedef __attribute__((ext_vector_type(16))) float f32x16;
typedef __attribute__((ext_vector_type(4))) int i32x4;
typedef __attribute__((ext_vector_type(2))) int i32x2;
typedef __attribute__((ext_vector_type(8))) int i32x8;
typedef __attribute__((ext_vector_type(2))) float f32x2;
typedef __attribute__((ext_vector_type(2))) __bf16 bf16v2;
typedef unsigned short u16;
typedef __attribute__((ext_vector_type(4))) unsigned u32x4;
typedef __attribute__((ext_vector_type(2))) unsigned u32x2;

constexpr int T_ = 16384, DM = 1024, SEQ = 4096;
constexpr int DINP = 2560;
constexpr float EPS = 1e-6f;
constexpr int NTHR = 512;

constexpr size_t OFF_BAR = 0;
constexpr size_t OFF_WIN = 16384;
constexpr size_t OFF_WUQ = OFF_WIN + 5242880;
constexpr size_t OFF_WUKV = OFF_WUQ + 393216;
constexpr size_t OFF_WOUT = OFF_WUKV + 262144;
constexpr size_t OFF_WPQ = OFF_WOUT + 2097152;
constexpr size_t OFF_K1 = OFF_WPQ + 4194304;
constexpr size_t OFF_K2 = OFF_K1 + 32768;
constexpr size_t OFF_SSQ = OFF_K2 + 32768;
constexpr size_t OFF_RA = OFF_SSQ + 1048576;
constexpr size_t OFF_U8 = OFF_RA;
constexpr size_t OFF_V8 = OFF_RA + 16777216;
constexpr size_t OFF_RSV = OFF_V8 + 8388608;
constexpr size_t OFF_RSU = OFF_RSV + 65536;
constexpr size_t OFF_RB = OFF_RA + 33554432;
constexpr size_t OFF_QM = OFF_RB;
constexpr size_t OFF_KM = OFF_RB + 16777216;
constexpr size_t OFF_OM = OFF_RB + 33554432;
constexpr size_t OFF_VT = OFF_RB + 50331648;
constexpr size_t OFF_QRY = OFF_RB;
constexpr size_t OFF_GI = OFF_RB + 67108864;
constexpr size_t OFF_GF = OFF_GI + 262144;
constexpr size_t OFF_MIX = OFF_GF + 262144;
constexpr size_t OFF_KT = OFF_MIX;
constexpr size_t OFF_LAT = OFF_MIX + 16777216;
constexpr size_t OFF_RC = OFF_MIX + 33554432;
constexpr size_t OFF_Q = OFF_RC;
constexpr size_t OFF_K = OFF_RC + 25165824;
constexpr size_t OFF_VTA = OFF_RC + 50331648;
constexpr size_t OFF_X1B = OFF_RC;
constexpr size_t OFF_RD = OFF_RC + 67108864;
constexpr size_t OFF_CST = OFF_RD;
constexpr size_t OFF_NST = OFF_RD + 33554432;
constexpr size_t OFF_MST = OFF_NST + 524288;
constexpr size_t OFF_SEL = OFF_RD;
constexpr size_t WS_NEED = OFF_MST + 4096;

struct Params {
  const float* x; const int* pos; const float* attn_g; const float* w_in; const float* b_i; const float* b_f;
  const float* mn_g; const float* cq_g; const float* w_uq; const float* ckv_g; const float* w_ukv; const float* q_g;
  const float* k_g; const float* w_out; const float* ffn_g; const float* pwq; const float* k1; const float* k2;
  const float* pu; const float* pv; float* out; char* ws;
};

DI float bf2f(short s) { return __uint_as_float(((unsigned)(unsigned short)s) << 16); }
DI unsigned pk2(float a, float b) { f32x2 v = {a, b}; bf16v2 r = __builtin_convertvector(v, bf16v2); return __builtin_bit_cast(unsigned, r); }
DI u16 f2bf(float a) { __bf16 r = (__bf16)a; return __builtin_bit_cast(u16, r); }
DI uint2 pk4(float a, float b, float c, float d) { return make_uint2(pk2(a, b), pk2(c, d)); }
DI float wave_sum(float v) { for (int o = 32; o > 0; o >>= 1) v += __shfl_xor(v, o); return v; }
DI float wave_max(float v) { for (int o = 32; o > 0; o >>= 1) v = fmaxf(v, __shfl_xor(v, o)); return v; }
DI int crow(int reg, int h) { return (reg & 3) + 8 * (reg >> 2) + 4 * h; }
#define MFMA32(a, b, c) __builtin_amdgcn_mfma_f32_32x32x16_bf16((a), (b), (c), 0, 0, 0)
#define MFMA16(a, b, c) __builtin_amdgcn_mfma_f32_16x16x32_bf16((a), (b), (c), 0, 0, 0)
DI f32x16 zero16() { f32x16 z; for (int i = 0; i < 16; ++i) z[i] = 0.f; return z; }

#define XB_TMO      128
#define XB_XCNT(j)  (256  + 64 * (j))
#define XB_XSUB(j)  (1280 + 64 * (j))
#define XB_XGEN(j)  (2304 + 64 * (j))
#define XB_TOP      3328
#define XB_TOPGEN   3392
#define XCD_BAR_WORDS 3456
#define XB_SPIN_CAP (1u << 18)
#define LAS __attribute__((address_space(3)))

DI unsigned xb_ld(unsigned* p)              { return __hip_atomic_load(p, __ATOMIC_RELAXED, __HIP_MEMORY_SCOPE_AGENT); }
DI unsigned xb_add(unsigned* p, unsigned v) { return __hip_atomic_fetch_add(p, v, __ATOMIC_RELAXED, __HIP_MEMORY_SCOPE_AGENT); }
DI unsigned xb_xcc_id() { return (unsigned)__builtin_amdgcn_s_getreg((3 << 11) | 20) & 0xFu; }
#define XB_SPIN(cond, bar) do { unsigned _sp = 0; while (cond) { __builtin_amdgcn_s_sleep(1); \
    if ((++_sp & 255u) == 0u) { if (xb_ld(&(bar)[XB_TMO])) break; if (_sp > XB_SPIN_CAP) { atomicAdd(&(bar)[XB_TMO], 1u); break; } } } } while (0)

struct XcdBarrier { unsigned* bar; unsigned x; volatile LAS unsigned* st; };

DI XcdBarrier xcd_barrier_post(unsigned* bar, volatile LAS unsigned* st) {
    XcdBarrier b; b.bar = bar; b.x = xb_xcc_id(); b.st = st;
    if (threadIdx.x == 0) (void)xb_add(&bar[XB_XCNT(b.x)], 1u);
    return b;
}
DI void xcd_barrier_complete(unsigned* bar, unsigned x, unsigned& nloc, unsigned& nx) {
    const unsigned G = gridDim.x * gridDim.y * gridDim.z;
    unsigned sum, cnt, mine, sp = 0u;
    for (;;) {
        sum = 0u; cnt = 0u; mine = 0u;
#pragma unroll
        for (unsigned j = 0; j < 16; ++j) { const unsigned c = xb_ld(&bar[XB_XCNT(j)]); sum += c; cnt += (c > 0u) ? 1u : 0u; mine = (j == x) ? c : mine; }
        if (sum == G) break;
        __builtin_amdgcn_s_sleep(1);
        if ((++sp & 255u) == 0u) { if (xb_ld(&bar[XB_TMO])) break; if (sp > XB_SPIN_CAP) { atomicAdd(&bar[XB_TMO], 1u); break; } }
    }
    nloc = mine > 0u ? mine : 1u; nx = cnt > 0u ? cnt : 1u;
}
DI void xcd_barrier(const XcdBarrier& b) {
    asm volatile("s_waitcnt vmcnt(0)" ::: "memory");
    __syncthreads();
    if (threadIdx.x == 0) {
        unsigned* bar = b.bar;
        __builtin_amdgcn_s_waitcnt(0);
        unsigned nloc = b.st[0], nx = b.st[1];
        if (nloc == 0u) { xcd_barrier_complete(bar, b.x, nloc, nx); b.st[0] = nloc; b.st[1] = nx; }
        const unsigned old = xb_add(&bar[XB_XSUB(b.x)], 1u);
        const unsigned gen = old / nloc;
        if (old + 1u == (gen + 1u) * nloc) {
            __builtin_amdgcn_fence(__ATOMIC_RELEASE, "agent");
            asm volatile("s_waitcnt vmcnt(0)" ::: "memory");
            const unsigned og = xb_add(&bar[XB_TOP], 1u);
            const unsigned tg = og / nx;
            if (og + 1u == (tg + 1u) * nx) xb_add(&bar[XB_TOPGEN], 1u);
            else XB_SPIN(xb_ld(&bar[XB_TOPGEN]) == tg, bar);
            __builtin_amdgcn_fence(__ATOMIC_ACQUIRE, "agent");
            xb_add(&bar[XB_XGEN(b.x)], 1u);
            asm volatile("s_waitcnt vmcnt(0)" ::: "memory");
        } else {
            XB_SPIN(xb_ld(&bar[XB_XGEN(b.x)]) == gen, bar);
            __builtin_amdgcn_fence(__ATOMIC_ACQUIRE, "agent");
            asm volatile("s_waitcnt vmcnt(0)" ::: "memory");
        }
    }
    __syncthreads();
}

DI void tconv(const float* __restrict__ src, int K, int N, int Npad, u16* __restrict__ dst, const float* __restrict__ g,
              int gtid, int gstride) {
  const int items = Npad * (K >> 3);
  for (int it = gtid; it < items; it += gstride) {
    const int n = it % Npad, kc = it / Npad;
    unsigned w[4];
#pragma unroll
    for (int j = 0; j < 4; ++j) {
      float a = 0.f, b = 0.f;
      if (n < N) {
        a = src[(size_t)(kc * 8 + 2 * j) * N + n]; b = src[(size_t)(kc * 8 + 2 * j + 1) * N + n];
        if (g) { a *= g[kc * 8 + 2 * j]; b *= g[kc * 8 + 2 * j + 1]; }
      }
      w[j] = pk2(a, b);
    }
    *(uint4*)(dst + (size_t)n * K + kc * 8) = make_uint4(w[0], w[1], w[2], w[3]);
  }
}

DI void late_weights(const Params& p, int cb, int ncb, int tid) {
  char* ws = p.ws;
  const int gtid = cb * NTHR + tid, gstride = ncb * NTHR;
  tconv(p.w_uq, 256, 768, 768, (u16*)(ws + OFF_WUQ), p.cq_g, gtid, gstride);
  tconv(p.w_ukv, 128, 1024, 1024, (u16*)(ws + OFF_WUKV), p.ckv_g, gtid, gstride);
  tconv(p.w_out, 1024, 1024, 1024, (u16*)(ws + OFF_WOUT), nullptr, gtid, gstride);
  tconv(p.pwq, 1024, 2048, 2048, (u16*)(ws + OFF_WPQ), p.ffn_g, gtid, gstride);
  for (int i = gtid; i < 16384; i += gstride) {
    ((u16*)(ws + OFF_K1))[i] = f2bf(p.k1[i]);
    ((u16*)(ws + OFF_K2))[i] = f2bf(p.k2[i]);
  }
}
DI void phase0(const Params& p, int bid, int nb, int tid) {
  char* ws = p.ws;
  const int gtid = bid * NTHR + tid, gstride = nb * NTHR;
  tconv(p.w_in, 1024, 2504, DINP, (u16*)(ws + OFF_WIN), nullptr, gtid, gstride);
  const int lane = tid & 63, gw = bid * 8 + (tid >> 6), nw = nb * 8;
  u16* hb = (u16*)(ws + OFF_RA);
  for (int r = gw; r < T_; r += nw) {
    const float4* xr = (const float4*)(p.x + (size_t)r * DM);
    float4 v[4]; float ss = 0.f;
#pragma unroll
    for (int i = 0; i < 4; ++i) { v[i] = xr[lane + 64 * i]; ss += v[i].x * v[i].x + v[i].y * v[i].y + v[i].z * v[i].z + v[i].w * v[i].w; }
    ss = wave_sum(ss);
    const float rstd = rsqrtf(ss * (1.f / 1024.f) + EPS);
#pragma unroll
    for (int i = 0; i < 4; ++i) {
      const float4 g4 = ((const float4*)p.attn_g)[lane + 64 * i];
      *(uint2*)(hb + (size_t)r * DM + 4 * (lane + 64 * i)) = pk4(v[i].x * rstd * g4.x, v[i].y * rstd * g4.y, v[i].z * rstd * g4.z, v[i].w * rstd * g4.w);
    }
  }
}

constexpr int G_BK = 64, G_KS = 2, G_TILE_B = 256 * G_BK * 2, G_STAGE_B = 2 * G_TILE_B, G_GL = G_TILE_B / 8192;
constexpr int LDS_GEMM_OFF = 2048;
DI int lds_byte(int r, int c) {
  int st = (r >> 4) * G_KS + (c >> 5), ob = (r & 15) * 64 + (c & 31) * 2;
  return st * 1024 + (ob ^ (((ob >> 9) & 1) << 5));
}
DI void stage_rc(int b, int& R, int& C) {
  int st = b >> 10, sb = b & 1023, swz = sb ^ (((sb >> 9) & 1) << 5);
  R = (st / G_KS) * 16 + swz / 64;
  C = (st % G_KS) * 32 + (swz % 64) / 2;
}
#define WAIT_V(n) asm volatile("s_waitcnt vmcnt(%0)" ::"n"(n) : "memory")

template <class Epi>
DI void gemm_tile(const u16* __restrict__ A, const u16* __restrict__ Bt, int K, int brow, int bcol, char* smem, int tid, Epi epi) {
  char* shm = smem + LDS_GEMM_OFF;
  const int wid = tid >> 6, lane = tid & 63, wr = wid >> 2, wc = wid & 3, fr = lane & 15, fq = lane >> 4;
  const u16* Ab = A + (size_t)brow * K;
  const u16* Bb = Bt + (size_t)bcol * K;
#define SA(b) (shm + (b) * G_STAGE_B)
#define SB(b) (shm + (b) * G_STAGE_B + G_TILE_B)
  int sR[G_GL], sC[G_GL];
#pragma unroll
  for (int i = 0; i < G_GL; ++i) stage_rc(wid * 1024 + i * 8192 + lane * 16, sR[i], sC[i]);
#define GSRC(base, i, kt) ((base) + (size_t)sR[i] * K + (kt) * G_BK + sC[i])
#define GLDS_STAGE(buf, kt) do { _Pragma("unroll") for (int i = 0; i < G_GL; ++i) { \
      __builtin_amdgcn_global_load_lds((const unsigned*)GSRC(Ab, i, kt), (LAS unsigned*)(SA(buf) + wid * 1024 + i * 8192), 16, 0, 0); \
      __builtin_amdgcn_global_load_lds((const unsigned*)GSRC(Bb, i, kt), (LAS unsigned*)(SB(buf) + wid * 1024 + i * 8192), 16, 0, 0); } } while (0)
  f32x4 acc[8][4];
#pragma unroll
  for (int m = 0; m < 8; ++m)
#pragma unroll
    for (int n = 0; n < 4; ++n) acc[m][n] = (f32x4){0.f, 0.f, 0.f, 0.f};
  const int nt = K / G_BK;
  GLDS_STAGE(0, 0); WAIT_V(0); __syncthreads();
  for (int t = 0; t < nt; ++t) {
    const int cur = t & 1;
    if (t + 1 < nt) GLDS_STAGE(cur ^ 1, t + 1);
#pragma unroll
    for (int ks = 0; ks < G_KS; ++ks) {
      bf16x8 At[8], Bf[4];
#pragma unroll
      for (int m = 0; m < 8; ++m) At[m] = *(const bf16x8*)(SA(cur) + lds_byte(wr * 128 + m * 16 + fr, ks * 32 + fq * 8));
#pragma unroll
      for (int n = 0; n < 4; ++n) Bf[n] = *(const bf16x8*)(SB(cur) + lds_byte(wc * 64 + n * 16 + fr, ks * 32 + fq * 8));
#pragma unroll
      for (int m = 0; m < 8; ++m)
#pragma unroll
        for (int n = 0; n < 4; ++n) acc[m][n] = MFMA16(At[m], Bf[n], acc[m][n]);
      __builtin_amdgcn_sched_barrier(0);
    }
    WAIT_V(0); __syncthreads();
  }
#pragma unroll
  for (int m = 0; m < 8; ++m)
#pragma unroll
    for (int n = 0; n < 4; ++n) epi(m, n, brow + wr * 128 + m * 16 + fq * 4, bcol + wc * 64 + n * 16 + fr, acc[m][n]);
#undef SA
#undef SB
#undef GSRC
#undef GLDS_STAGE
}
constexpr int G8_HALF = 128, G8_HT = G8_HALF * 64;
DI int lds_byte8(int r, int c) {
  int st = (r >> 4) * 2 + (c >> 5), rr = r & 15, cc = c & 31, ob = rr * 64 + cc * 2;
  return st * 1024 + (ob ^ (((ob >> 9) & 1) << 5));
}
DI void stage_rc8(int b, int& R, int& C) {
  int st = b / 1024, sb = b % 1024, swz = sb ^ (((sb >> 9) & 1) << 5);
  R = (st >> 1) * 16 + swz / 64; C = (st & 1) * 32 + (swz % 64) / 2;
}
struct NoPre { DI void operator()(int, int, int, int) const {} };
template <class Epi, class Pre = NoPre>
DI void gemm_tile8(const u16* __restrict__ A, const u16* __restrict__ Bt, int K, int brow, int bcol, char* smem, Epi epi, Pre pre = Pre()) {
  u16* shm = (u16*)(smem + LDS_GEMM_OFF);
#define SA8(b, h) (shm + ((b) * 2 + (h)) * G8_HT)
#define SB8(b, h) (shm + (4 + (b) * 2 + (h)) * G8_HT)
#define STAGE_X8(T, P, BASE, br, kt) do { const unsigned _g = (unsigned)(br) * (unsigned)K + (unsigned)(kt) * 64u; \
    _Pragma("unroll") for (int _i = 0; _i < 2; ++_i) { int _b = (T) * 16 + _i * 8192; int _r, _c; stage_rc8(_b, _r, _c); \
      __builtin_amdgcn_global_load_lds((const unsigned*)((const char*)(BASE) + (size_t)((_g + (unsigned)_r * (unsigned)K + (unsigned)_c) * 2u)), (LAS unsigned*)((char*)(P) + _b), 16, 0, 0); } } while (0)
#define STAGE8(P, BASE, br, kt) STAGE_X8(threadIdx.x, P, BASE, br, kt)
#define LDA8(dst, b, h) _Pragma("unroll") for (int m = 0; m < 4; ++m) _Pragma("unroll") for (int k = 0; k < 2; ++k) \
    dst[m][k] = *reinterpret_cast<const bf16x8*>((char*)SA8(b, h) + lds_byte8(wr * 64 + m * 16 + fr, k * 32 + fq * 8))
#define LDB8(dst, b, h) _Pragma("unroll") for (int n = 0; n < 2; ++n) _Pragma("unroll") for (int k = 0; k < 2; ++k) \
    dst[n][k] = *reinterpret_cast<const bf16x8*>((char*)SB8(b, h) + lds_byte8(wc * 32 + n * 16 + fr, k * 32 + fq * 8))
#define MMA8(ai, bj, At_, Bt_) do { __builtin_amdgcn_s_setprio(1); \
    _Pragma("unroll") for (int m = 0; m < 4; ++m) _Pragma("unroll") for (int n = 0; n < 2; ++n) _Pragma("unroll") for (int k = 0; k < 2; ++k) \
      acc[ai][bj][m][n] = MFMA16(At_[m][k], Bt_[n][k], acc[ai][bj][m][n]); \
    __builtin_amdgcn_s_setprio(0); } while (0)
#define WAIT_V8(n) asm volatile("s_waitcnt vmcnt(" #n ")" ::: "memory")
#define WAIT_L8(n) asm volatile("s_waitcnt lgkmcnt(" #n ")" ::: "memory")
#define BAR8 __builtin_amdgcn_s_barrier()
#define SCHED8 __builtin_amdgcn_sched_barrier(0)
  int wid = threadIdx.x >> 6, lane = threadIdx.x & 63, wr = wid >> 2, wc = wid & 3, fr = lane & 15, fq = lane >> 4;
  f32x4 acc[2][2][4][2];
#pragma unroll
  for (int a = 0; a < 2; ++a)
#pragma unroll
    for (int b = 0; b < 2; ++b)
#pragma unroll
      for (int m = 0; m < 4; ++m)
#pragma unroll
        for (int n = 0; n < 2; ++n) acc[a][b][m][n] = (f32x4){0.f, 0.f, 0.f, 0.f};
  bf16x8 At[4][2], B0[2][2], B1[2][2];
  const int nt = K / 64;
  STAGE8(SB8(0, 0), Bt, bcol, 0); STAGE8(SA8(0, 0), A, brow, 0);
  STAGE8(SB8(0, 1), Bt, bcol + G8_HALF, 0); STAGE8(SA8(0, 1), A, brow + G8_HALF, 0);
  if (wr == 1) BAR8;
  WAIT_V8(4); BAR8;
  STAGE8(SB8(1, 0), Bt, bcol, 1); STAGE8(SA8(1, 0), A, brow, 1); STAGE8(SB8(1, 1), Bt, bcol + G8_HALF, 1);
  WAIT_V8(6); BAR8;
  for (int t = 0; t < nt - 2; t += 2) {
    LDB8(B0, 0, 0); SCHED8; LDA8(At, 0, 0); STAGE8(SA8(1, 1), A, brow + G8_HALF, t + 1);
    WAIT_L8(8); BAR8; WAIT_L8(0); MMA8(0, 0, At, B0); BAR8; SCHED8;
    LDB8(B1, 0, 1); STAGE8(SB8(0, 0), Bt, bcol, t + 2);
    BAR8; WAIT_L8(0); MMA8(0, 1, At, B1); BAR8;
    LDA8(At, 0, 1); STAGE8(SA8(0, 0), A, brow, t + 2);
    BAR8; WAIT_L8(0); MMA8(1, 0, At, B0); BAR8; SCHED8;
    STAGE8(SB8(0, 1), Bt, bcol + G8_HALF, t + 2);
    WAIT_V8(6); BAR8; MMA8(1, 1, At, B1); BAR8;
    LDB8(B0, 1, 0); SCHED8; LDA8(At, 1, 0); STAGE8(SA8(0, 1), A, brow + G8_HALF, t + 2);
    WAIT_L8(8); BAR8; WAIT_L8(0); MMA8(0, 0, At, B0); BAR8; SCHED8;
    LDB8(B1, 1, 1); STAGE8(SB8(1, 0), Bt, bcol, t + 3);
    BAR8; WAIT_L8(0); MMA8(0, 1, At, B1); BAR8;
    LDA8(At, 1, 1); STAGE8(SA8(1, 0), A, brow, t + 3);
    BAR8; WAIT_L8(0); MMA8(1, 0, At, B0); BAR8; SCHED8;
    STAGE8(SB8(1, 1), Bt, bcol + G8_HALF, t + 3);
    WAIT_V8(6); BAR8; MMA8(1, 1, At, B1); BAR8;
  }
  int tz = threadIdx.x; asm volatile("" : "+v"(tz)); wid = tz >> 6; lane = tz & 63; wr = wid >> 2; wc = wid & 3; fr = lane & 15; fq = lane >> 4;
  { LDB8(B0, 0, 0); WAIT_V8(0); LDA8(At, 0, 0); STAGE_X8(tz, SA8(1, 1), A, brow + G8_HALF, nt - 1);
    BAR8; WAIT_L8(0); MMA8(0, 0, At, B0); BAR8;
    LDB8(B1, 0, 1); BAR8; WAIT_L8(0); MMA8(0, 1, At, B1); BAR8;
    LDA8(At, 0, 1); WAIT_V8(4); BAR8; WAIT_L8(0); MMA8(1, 0, At, B0); MMA8(1, 1, At, B1); BAR8; }
  { LDB8(B0, 1, 0); LDA8(At, 1, 0); WAIT_V8(2); BAR8; WAIT_L8(0); MMA8(0, 0, At, B0); BAR8;
    LDB8(B1, 1, 1); WAIT_V8(0); BAR8; WAIT_L8(0); MMA8(0, 1, At, B1); BAR8;
    LDA8(At, 1, 1); BAR8; WAIT_L8(0); MMA8(1, 0, At, B0); MMA8(1, 1, At, B1); BAR8; }
  if (wr == 0) BAR8;
  __syncthreads();
#pragma unroll
  for (int ai = 0; ai < 2; ++ai)
#pragma unroll
    for (int m = 0; m < 4; ++m) {
#pragma unroll
      for (int bj = 0; bj < 2; ++bj)
#pragma unroll
        for (int n = 0; n < 2; ++n)
          pre(ai * 4 + m, bj * 2 + n, brow + ai * G8_HALF + wr * 64 + m * 16 + fq * 4, bcol + bj * G8_HALF + wc * 32 + n * 16 + fr);
#pragma unroll
      for (int bj = 0; bj < 2; ++bj)
#pragma unroll
        for (int n = 0; n < 2; ++n)
          epi(ai * 4 + m, bj * 2 + n, brow + ai * G8_HALF + wr * 64 + m * 16 + fq * 4, bcol + bj * G8_HALF + wc * 32 + n * 16 + fr, acc[ai][bj][m][n]);
    }
  __syncthreads();
#undef SA8
#undef SB8
}
DI int xcd_unit(int u, int nunits) { return (u & 7) * (nunits >> 3) + (u >> 3); }

struct Epi1 {
  char* ws; const float* dummy;
  DI void st16(unsigned off, float v) const { *(u16*)(ws + off) = f2bf(v); }
  DI void operator()(int, int, int r0, int c, f32x4 v) const {
    if (c < 512) {
#pragma unroll
      for (int j = 0; j < 4; ++j) st16((unsigned)OFF_QM + ((unsigned)(r0 + j) * 512u + (unsigned)c) * 2u, v[j]);
    } else if (c < 1024) {
      const int cc = c - 512; const float sc = 0.08838834764831845f;
#pragma unroll
      for (int j = 0; j < 4; ++j) st16((unsigned)OFF_KM + ((unsigned)(r0 + j) * 512u + (unsigned)cc) * 2u, v[j] * sc);
      const int b = r0 >> 12, s = r0 & 4095, hd = cc >> 7, d = cc & 127;
      *(uint2*)(ws + ((unsigned)OFF_KT + ((unsigned)((b * 4 + hd) * 128 + d) * 4096u + (unsigned)s) * 2u)) = pk4(v[0] * sc, v[1] * sc, v[2] * sc, v[3] * sc);
    } else if (c < 1536) {
      const int cc = c - 1024;
      const int b = r0 >> 12, s = r0 & 4095, hd = cc >> 7, d = cc & 127;
      *(uint2*)(ws + ((unsigned)OFF_VT + ((unsigned)((b * 4 + hd) * 128 + d) * 4096u + (unsigned)s) * 2u)) = pk4(v[0], v[1], v[2], v[3]);
    } else if (c < 2048) {
#pragma unroll
      for (int j = 0; j < 4; ++j) st16((unsigned)OFF_OM + ((unsigned)(r0 + j) * 512u + (unsigned)(c - 1536)) * 2u, v[j]);
    } else if (c < 2052) {
#pragma unroll
      for (int j = 0; j < 4; ++j) *(float*)(ws + ((unsigned)OFF_GI + ((unsigned)(r0 + j) * 4u + (unsigned)(c - 2048)) * 4u)) = v[j];
    } else if (c < 2056) {
#pragma unroll
      for (int j = 0; j < 4; ++j) *(float*)(ws + ((unsigned)OFF_GF + ((unsigned)(r0 + j) * 4u + (unsigned)(c - 2052)) * 4u)) = v[j];
    } else if (c < 2504) {
#pragma unroll
      for (int j = 0; j < 4; ++j) st16((unsigned)OFF_LAT + ((unsigned)(r0 + j) * 448u + (unsigned)(c - 2056)) * 2u, v[j]);
    }
  }
};
DI void phase1(const Params& p, int bid, int nb, int tid, char* smem) {
  const int nunits = 64 * 10;
  Epi1 e{p.ws, nullptr};
  for (int u = bid; u < nunits; u += nb) {
    const int v = xcd_unit(u, nunits), pm = v / 10, pn = v % 10;
    gemm_tile8((const u16*)(p.ws + OFF_RA), (const u16*)(p.ws + OFF_WIN), 1024, pm * 256, pn * 256, smem, e);
  }
  const int nfull = nunits % nb;
  if (nfull > 0 && nfull < nb) { if (bid >= nfull) late_weights(p, bid - nfull, nb - nfull, tid); }
  else late_weights(p, bid, nb, tid);
}

DI float logsig(float z) { return fminf(z, 0.f) - log1pf(__expf(-fabsf(z))); }

constexpr int SC_DC = 32 * 136 * 2;
DI void mlstm_scan(const Params& p, int item, char* smem, int tid) {
  asm volatile("" : "+v"(tid));
  char* ws = p.ws;
  const int bh = item >> 2, dq = item & 3;
  const int b = bh >> 2, hd = bh & 3;
  float* s_u = (float*)(smem + 1024);
  float* s_mx = s_u + 4096;
  float* s_bL = s_mx + 64;
  float* s_dec = s_bL + 64;
  float* s_M = s_dec + 64;
  float* s_dn = s_M + 64;
  char* s_dc = (char*)(s_dn + 1024);
  const float* gi = (const float*)(ws + OFF_GI);
  const float* gf = (const float*)(ws + OFF_GF);
  const float bi = p.b_i[hd], bfv = p.b_f[hd];
  const int w = tid >> 6, lane = tid & 63;
  {
    float gfv[8], giv[8];
#pragma unroll
    for (int i = 0; i < 8; ++i) {
      const size_t t = (size_t)b * 4096 + (w + 8 * i) * 64 + lane;
      gfv[i] = gf[t * 4 + hd]; giv[i] = gi[t * 4 + hd];
    }
#pragma unroll
    for (int i = 0; i < 8; ++i) {
      const int c = w + 8 * i;
      const float lf = logsig(gfv[i] + bfv), ip = giv[i] + bi;
      float bc = lf;
#pragma unroll
      for (int o = 1; o < 64; o <<= 1) { const float t2 = __shfl_up(bc, o); if (lane >= o) bc += t2; }
      const float u = ip - bc;
      const float mx = wave_max(u);
      s_u[c * 64 + lane] = u;
      if (lane == 63) { s_bL[c] = bc; s_mx[c] = mx; }
    }
  }
  __syncthreads();
  if (tid < 64) {
    float A = s_bL[tid], B = s_mx[tid] + A;
    const float mxc = s_mx[tid];
#pragma unroll
    for (int o = 1; o < 64; o <<= 1) {
      const float Ap = __shfl_up(A, o), Bp = __shfl_up(B, o);
      if (tid >= o) { B = fmaxf(Bp + A, B); A = Ap + A; }
    }
    const float mnext = fmaxf(A, B);
    float m = __shfl_up(mnext, 1);
    if (tid == 0) m = 0.f;
    const float M63 = fmaxf(m, mxc);
    s_M[tid] = M63; s_dec[tid] = __expf(m - M63);
    if (dq == 0) ((float*)(ws + OFF_MST))[bh * 64 + tid] = m;
  }
  __syncthreads();
  for (int s = tid; s < 4096; s += NTHR) s_u[s] = __expf(s_u[s] - s_M[s >> 6]);
  __syncthreads();
  const float* s_w = s_u;
  const int r = lane & 31, h = lane >> 5;
  const u16* ka = (const u16*)(ws + OFF_KT) + ((size_t)bh * 128 + r) * 4096 + 8 * h;
  const u16* vb = (const u16*)(ws + OFF_VT) + ((size_t)bh * 128 + 32 * dq + r) * 4096 + 8 * h;
  float Cs[8];
#pragma unroll
  for (int i = 0; i < 8; ++i) Cs[i] = 0.f;
  float ns = 0.f;
  u16* cst = (u16*)(ws + OFF_CST) + (size_t)bh * 64 * 16384 + (size_t)(32 * dq + (tid >> 4)) * 128 + (tid & 15) * 8;
  float* nst = (float*)(ws + OFF_NST) + (size_t)bh * 64 * 128 + tid;
  bf16x8 bv[4], a[4][4];
  auto lfr = [&](int c) {
#pragma unroll
    for (int ks = 0; ks < 4; ++ks) bv[ks] = *(const bf16x8*)(vb + 64 * c + 16 * ks);
#pragma unroll
    for (int ks = 0; ks < 4; ++ks)
#pragma unroll
      for (int kt = 0; kt < 4; ++kt) a[ks][kt] = *(const bf16x8*)(ka + (size_t)kt * 32 * 4096 + 64 * c + 16 * ks);
  };
  lfr(w);
#pragma unroll 1
  for (int j = 0; j < 8; ++j) {
    const int c = 8 * j + w;
    f32x16 D[4];
#pragma unroll
    for (int i = 0; i < 4; ++i) D[i] = zero16();
    float dn[4] = {0.f, 0.f, 0.f, 0.f};
#pragma unroll
    for (int ks = 0; ks < 4; ++ks) {
      const float4 w0 = *(const float4*)(s_w + c * 64 + 16 * ks + 8 * h), w1 = *(const float4*)(s_w + c * 64 + 16 * ks + 8 * h + 4);
      i32x4 bs;
      bs[0] = (int)pk2(bf2f(bv[ks][0]) * w0.x, bf2f(bv[ks][1]) * w0.y); bs[1] = (int)pk2(bf2f(bv[ks][2]) * w0.z, bf2f(bv[ks][3]) * w0.w);
      bs[2] = (int)pk2(bf2f(bv[ks][4]) * w1.x, bf2f(bv[ks][5]) * w1.y); bs[3] = (int)pk2(bf2f(bv[ks][6]) * w1.z, bf2f(bv[ks][7]) * w1.w);
      const bf16x8 bsv = __builtin_bit_cast(bf16x8, bs);
#pragma unroll
      for (int kt = 0; kt < 4; ++kt) {
        D[kt] = MFMA32(a[ks][kt], bsv, D[kt]);
        if (dq == 0)
          dn[kt] += bf2f(a[ks][kt][0]) * w0.x + bf2f(a[ks][kt][1]) * w0.y + bf2f(a[ks][kt][2]) * w0.z + bf2f(a[ks][kt][3]) * w0.w
                  + bf2f(a[ks][kt][4]) * w1.x + bf2f(a[ks][kt][5]) * w1.y + bf2f(a[ks][kt][6]) * w1.z + bf2f(a[ks][kt][7]) * w1.w;
      }
    }
    if (j < 7) lfr(c + 8);
    char* img = s_dc + w * SC_DC + r * 272 + 8 * h;
#pragma unroll
    for (int kt = 0; kt < 4; ++kt)
#pragma unroll
      for (int g = 0; g < 4; ++g) *(uint2*)(img + (32 * kt + 8 * g) * 2) = pk4(D[kt][4 * g], D[kt][4 * g + 1], D[kt][4 * g + 2], D[kt][4 * g + 3]);
    if (dq == 0) {
#pragma unroll
      for (int kt = 0; kt < 4; ++kt) { const float tn = dn[kt] + __shfl_xor(dn[kt], 32); if (h == 0) s_dn[w * 128 + 32 * kt + r] = tn; }
    }
    __syncthreads();
#pragma unroll
    for (int cc = 0; cc < 8; ++cc) {
      const int cg = 8 * j + cc;
      *(uint4*)(cst + (size_t)cg * 16384) = make_uint4(pk2(Cs[0], Cs[1]), pk2(Cs[2], Cs[3]), pk2(Cs[4], Cs[5]), pk2(Cs[6], Cs[7]));
      const float dec = s_dec[cg];
      const bf16x8 dv = *(const bf16x8*)(s_dc + cc * SC_DC + (tid >> 4) * 272 + (tid & 15) * 16);
#pragma unroll
      for (int i = 0; i < 8; ++i) Cs[i] = Cs[i] * dec + bf2f(dv[i]);
      if (dq == 0 && tid < 128) { nst[(size_t)cg * 128] = ns; ns = ns * dec + s_dn[cc * 128 + tid]; }
    }
    __syncthreads();
  }
}

constexpr int MP_QP = 528, MP_KP = 272;
DI void rope_sc(float posf, int j, float& sv, float& cv) {
  const float invf = exp2f(-(float)j * (13.287712379549449f / 32.f));
  double rev = (double)posf * (double)invf * 0.15915494309189535;
  rev -= __builtin_rint(rev);
  const float fr_ = (float)rev;
  sv = __builtin_amdgcn_sinf(fr_); cv = __builtin_amdgcn_cosf(fr_);
}
DI void mla_prep(const Params& p, int item, char* smem, int tid) {
  asm volatile("" : "+v"(tid));
  char* ws = p.ws;
  char* wl = smem + 1024;
  const int tile = item >> 2, hd = item & 3;
  const int w = tid >> 6, lane = tid & 63, r = lane & 31, h = lane >> 5;
  const int t = tile * 256 + w * 32 + r;
  const int b = t >> 12, s = t & 4095, bh = b * 4 + hd;
  const u16* lat = (const u16*)(ws + OFF_LAT) + (size_t)t * 448;
  const float posf = (float)p.pos[t];
  float* s_qg = (float*)(smem + 1024 + 103424);
  float* s_kg = s_qg + 192;
  const float* q_gp = s_qg; const float* k_gp = s_kg;
  if (tid < 48) ((float4*)s_qg)[tid] = ((const float4*)p.q_g)[tid];
  else if (tid < 96) ((float4*)s_kg)[tid - 48] = ((const float4*)p.k_g)[tid - 48];
  int hro = h; asm volatile("" : "+v"(hro));
  __syncthreads();
  {
    int tw = tid; asm volatile("" : "+v"(tw));
    const u16* sp = (const u16*)(ws + OFF_WUQ) + (size_t)hd * 192 * 256 + (tw >> 5) * 256 + (tw & 31) * 8;
    char* lp = wl + (tw >> 5) * MP_QP + (tw & 31) * 16;
#pragma unroll
    for (int hb = 0; hb < 2; ++hb) {
      i32x4 wv[6];
#pragma unroll
      for (int k = 0; k < 6; ++k) wv[k] = *(const i32x4*)(sp + (6 * hb + k) * 4096);
#pragma unroll
      for (int k = 0; k < 6; ++k) *(i32x4*)(lp + (6 * hb + k) * 16 * MP_QP) = wv[k];
    }
  }
  bf16x8 bq[6];
#pragma unroll
  for (int ks = 0; ks < 6; ++ks) bq[ks] = *(const bf16x8*)(lat + 16 * ks + 8 * h);
  __syncthreads();
  {
    f32x16 acc[6];
#pragma unroll
    for (int i = 0; i < 6; ++i) acc[i] = zero16();
    float ssq = 0.f;
#pragma unroll
    for (int ks = 0; ks < 16; ++ks) {
      const bf16x8 bcur = bq[ks % 6];
      if (ks + 6 < 16) bq[ks % 6] = *(const bf16x8*)(lat + 16 * (ks + 6) + 8 * h);
#pragma unroll
      for (int j = 0; j < 8; ++j) { const float f = bf2f(bcur[j]); ssq = fmaf(f, f, ssq); }
#pragma unroll
      for (int ft = 0; ft < 6; ++ft) {
        const bf16x8 a = *(const bf16x8*)(wl + (32 * ft + r) * MP_QP + 32 * ks + 16 * h);
        acc[ft] = MFMA32(a, bcur, acc[ft]);
      }
      __builtin_amdgcn_sched_barrier(0);
    }
    ssq += __shfl_xor(ssq, 32);
    const float rstd = rsqrtf(ssq * (1.f / 256.f) + EPS);
    float sq = 0.f;
#pragma unroll
    for (int ft = 0; ft < 6; ++ft)
#pragma unroll
      for (int i = 0; i < 16; ++i) { acc[ft][i] *= rstd; sq = fmaf(acc[ft][i], acc[ft][i], sq); }
    sq += __shfl_xor(sq, 32);
    const float rq = rsqrtf(sq * (1.f / 192.f) + EPS) * (0.07216878364870323f * 1.4426950408889634f);
    __syncthreads();
    int tq = tid; asm volatile("" : "+v"(tq));
    char* qo = wl + (tq >> 6) * 12800 + (tq & 31) * 400;
    asm volatile("" ::: "memory");
#pragma unroll
    for (int ft = 0; ft < 4; ++ft)
#pragma unroll
      for (int g = 0; g < 4; ++g) {
        const int f0 = 32 * ft + 8 * g + 4 * h;
        const float4 gg = *(const float4*)(q_gp + f0);
        *(uint2*)(qo + 2 * f0) = pk4(acc[ft][4 * g] * rq * gg.x, acc[ft][4 * g + 1] * rq * gg.y, acc[ft][4 * g + 2] * rq * gg.z, acc[ft][4 * g + 3] * rq * gg.w);
      }
    __builtin_amdgcn_sched_barrier(0);
#pragma unroll
    for (int g = 0; g < 4; ++g) {
      const int j0 = 8 * g + 4 * h;
      const float4 g1 = *(const float4*)(q_gp + 128 + j0), g2 = *(const float4*)(q_gp + 160 + j0);
      const float g1a[4] = {g1.x, g1.y, g1.z, g1.w}, g2a[4] = {g2.x, g2.y, g2.z, g2.w};
      float o1[4], o2[4];
#pragma unroll
      for (int q = 0; q < 4; ++q) {
        const float r1 = acc[4][4 * g + q] * rq * g1a[q], r2 = acc[5][4 * g + q] * rq * g2a[q];
        float sv, cv; rope_sc(posf, 8 * g + 4 * hro + q, sv, cv);
        o1[q] = r1 * cv - r2 * sv;
        o2[q] = r1 * sv + r2 * cv;
      }
      *(uint2*)(qo + 2 * (128 + j0)) = pk4(o1[0], o1[1], o1[2], o1[3]);
      *(uint2*)(qo + 2 * (160 + j0)) = pk4(o2[0], o2[1], o2[2], o2[3]);
    }
    __syncthreads();
    {
      int tz = tid; asm volatile("" : "+v"(tz));
      const int wz = tz >> 6, lz = tz & 63, t_w = tile * 256 + wz * 32;
      char* gq = (char*)((u16*)(ws + OFF_Q) + ((size_t)((t_w >> 12) * 4 + hd) * 4096 + (t_w & 4095)) * 192);
      const char* st = wl + wz * 12800;
#pragma unroll
      for (int k = 0; k < 12; ++k) {
        const int idx = lz + 64 * k, row = idx / 24, ch = idx - 24 * row;
        *(i32x4*)(gq + 16 * idx) = *(const i32x4*)(st + row * 400 + 16 * ch);
      }
    }
  }
  __syncthreads();
  {
    int tw = tid; asm volatile("" : "+v"(tw));
    const u16* sp = (const u16*)(ws + OFF_WUKV) + (size_t)hd * 256 * 128 + (tw >> 4) * 128 + (tw & 15) * 8;
    char* lp = wl + (tw >> 4) * MP_KP + (tw & 15) * 16;
    i32x4 wv[8];
#pragma unroll
    for (int k = 0; k < 8; ++k) wv[k] = *(const i32x4*)(sp + k * 4096);
#pragma unroll
    for (int k = 0; k < 8; ++k) *(i32x4*)(lp + k * 32 * MP_KP) = wv[k];
  }
  bf16x8 bk[8];
#pragma unroll
  for (int ks = 0; ks < 8; ++ks) bk[ks] = *(const bf16x8*)(lat + 256 + 16 * ks + 8 * h);
  __syncthreads();
  float rstd_kv;
  {
    f32x16 acc[4];
#pragma unroll
    for (int i = 0; i < 4; ++i) acc[i] = zero16();
    float ssq = 0.f;
#pragma unroll
    for (int ks = 0; ks < 8; ++ks) {
#pragma unroll
      for (int j = 0; j < 8; ++j) { const float f = bf2f(bk[ks][j]); ssq = fmaf(f, f, ssq); }
#pragma unroll
      for (int ft = 0; ft < 4; ++ft) {
        const bf16x8 a = *(const bf16x8*)(wl + (128 + 32 * ft + r) * MP_KP + 32 * ks + 16 * h);
        acc[ft] = MFMA32(a, bk[ks], acc[ft]);
      }
    }
    ssq += __shfl_xor(ssq, 32);
    rstd_kv = rsqrtf(ssq * (1.f / 128.f) + EPS);
    int tq = tid; asm volatile("" : "+v"(tq));
    const int t_q = tile * 256 + (tq >> 6) * 32 + (tq & 31), bh_q = (t_q >> 12) * 4 + hd, s_q = t_q & 4095;
    u16* vo = (u16*)(ws + OFF_VTA) + (size_t)bh_q * 128 * 4096 + s_q + (size_t)(4 * ((tq >> 5) & 1)) * 4096;
#pragma unroll
    for (int vt = 0; vt < 4; ++vt)
#pragma unroll
      for (int g = 0; g < 4; ++g) {
        u16* vp = vo + (size_t)(32 * vt + 8 * g) * 4096;
        asm volatile("" : "+v"(vp));
#pragma unroll
        for (int q = 0; q < 4; ++q) vp[q * 4096] = f2bf(acc[vt][4 * g + q] * rstd_kv);
      }
  }
  {
    f32x16 acc[4];
#pragma unroll
    for (int i = 0; i < 4; ++i) acc[i] = zero16();
#pragma unroll
    for (int ks = 0; ks < 8; ++ks) {
#pragma unroll
      for (int ft = 0; ft < 4; ++ft) {
        const bf16x8 a = *(const bf16x8*)(wl + (32 * ft + r) * MP_KP + 32 * ks + 16 * h);
        acc[ft] = MFMA32(a, bk[ks], acc[ft]);
      }
    }
    float kr1[16], kr2[16]; float skr = 0.f;
#pragma unroll
    for (int g = 0; g < 4; ++g) {
      const uint2 a1 = *(const uint2*)(lat + 384 + 8 * g + 4 * h), a2 = *(const uint2*)(lat + 416 + 8 * g + 4 * h);
      kr1[4 * g] = bf2f((short)(a1.x & 0xffff)); kr1[4 * g + 1] = bf2f((short)(a1.x >> 16)); kr1[4 * g + 2] = bf2f((short)(a1.y & 0xffff)); kr1[4 * g + 3] = bf2f((short)(a1.y >> 16));
      kr2[4 * g] = bf2f((short)(a2.x & 0xffff)); kr2[4 * g + 1] = bf2f((short)(a2.x >> 16)); kr2[4 * g + 2] = bf2f((short)(a2.y & 0xffff)); kr2[4 * g + 3] = bf2f((short)(a2.y >> 16));
    }
#pragma unroll
    for (int i = 0; i < 16; ++i) { skr = fmaf(kr1[i], kr1[i], skr); skr = fmaf(kr2[i], kr2[i], skr); }
    float sk = skr;
#pragma unroll
    for (int ft = 0; ft < 4; ++ft)
#pragma unroll
      for (int i = 0; i < 16; ++i) { acc[ft][i] *= rstd_kv; sk = fmaf(acc[ft][i], acc[ft][i], sk); }
    sk += __shfl_xor(sk, 32);
    const float rk = rsqrtf(sk * (1.f / 192.f) + EPS);
    __syncthreads();
    int tq = tid; asm volatile("" : "+v"(tq));
    char* ko = wl + (tq >> 6) * 12800 + (tq & 31) * 400;
    asm volatile("" ::: "memory");
#pragma unroll
    for (int ft = 0; ft < 4; ++ft)
#pragma unroll
      for (int g = 0; g < 4; ++g) {
        const int f0 = 32 * ft + 8 * g + 4 * h;
        const float4 gg = *(const float4*)(k_gp + f0);
        *(uint2*)(ko + 2 * f0) = pk4(acc[ft][4 * g] * rk * gg.x, acc[ft][4 * g + 1] * rk * gg.y, acc[ft][4 * g + 2] * rk * gg.z, acc[ft][4 * g + 3] * rk * gg.w);
      }
    __builtin_amdgcn_sched_barrier(0);
#pragma unroll
    for (int g = 0; g < 4; ++g) {
      const int j0 = 8 * g + 4 * h;
      const float4 g1 = *(const float4*)(k_gp + 128 + j0), g2 = *(const float4*)(k_gp + 160 + j0);
      const float g1a[4] = {g1.x, g1.y, g1.z, g1.w}, g2a[4] = {g2.x, g2.y, g2.z, g2.w};
      float o1[4], o2[4];
#pragma unroll
      for (int q = 0; q < 4; ++q) {
        const float r1 = kr1[4 * g + q] * rk * g1a[q], r2 = kr2[4 * g + q] * rk * g2a[q];
        float sv, cv; rope_sc(posf, 8 * g + 4 * hro + q, sv, cv);
        o1[q] = r1 * cv - r2 * sv;
        o2[q] = r1 * sv + r2 * cv;
      }
      *(uint2*)(ko + 2 * (128 + j0)) = pk4(o1[0], o1[1], o1[2], o1[3]);
      *(uint2*)(ko + 2 * (160 + j0)) = pk4(o2[0], o2[1], o2[2], o2[3]);
    }
    __syncthreads();
    {
      int tz = tid; asm volatile("" : "+v"(tz));
      const int wz = tz >> 6, lz = tz & 63, t_w = tile * 256 + wz * 32;
      char* gk = (char*)((u16*)(ws + OFF_K) + ((size_t)((t_w >> 12) * 4 + hd) * 4096 + (t_w & 4095)) * 192);
      const char* st = wl + wz * 12800;
#pragma unroll
      for (int k = 0; k < 12; ++k) {
        const int idx = lz + 64 * k, row = idx / 24, ch = idx - 24 * row;
        *(i32x4*)(gk + 16 * idx) = *(const i32x4*)(st + row * 400 + 16 * ch);
      }
    }
  }
}

DI float wave_max_pos(float v) {
#define WMX(CTRL, RM) v = fmaxf(v, __int_as_float(__builtin_amdgcn_update_dpp(0, __float_as_int(v), CTRL, RM, 0xF, false)))
  WMX(0xB1, 0xF); WMX(0x4E, 0xF); WMX(0x141, 0xF); WMX(0x140, 0xF); WMX(0x142, 0xA); WMX(0x143, 0xC);
#undef WMX
  return __int_as_float(__builtin_amdgcn_readlane(__float_as_int(v), 63));
}
DI unsigned pack_fp4x4(const float4 c, const float inv) {
  const unsigned p0 = __builtin_amdgcn_cvt_scalef32_pk_fp4_f32(0u, c.x * inv, c.y * inv, 1.0f, 0);
  const unsigned p1 = __builtin_amdgcn_cvt_scalef32_pk_fp4_f32(0u, c.z * inv, c.w * inv, 1.0f, 0);
  return (p0 & 0xFFu) | ((p1 & 0xFFu) << 8);
}
DI void tables_fp8_chunk(const Params& p, int chunk, int tid) {
  asm volatile("" : "+v"(tid));
  char* ws = p.ws;
  const int lane = tid & 63, w = tid >> 6;
  const float4* pu4 = (const float4*)p.pu; const float4* pv4 = (const float4*)p.pv;
  u16* u4 = (u16*)(ws + OFF_U8); u16* v4 = (u16*)(ws + OFF_V8);
  float* rsu = (float*)(ws + OFF_RSU); float* rsv = (float*)(ws + OFF_RSV);
  float4 g[4];
#pragma unroll
  for (int q = 0; q < 4; ++q) g[q] = ((const float4*)p.ffn_g)[lane + 64 * q];
#pragma unroll 1
  for (int r2 = 0; r2 < 2; ++r2) {
    const int row0 = chunk * 64 + w * 8 + r2 * 4;
    float4 a[4][4], c[4][4];
#pragma unroll
    for (int r = 0; r < 4; ++r)
#pragma unroll
      for (int q = 0; q < 4; ++q) { a[r][q] = pu4[(row0 + r) * 256 + lane + 64 * q]; c[r][q] = pv4[(row0 + r) * 256 + lane + 64 * q]; }
#pragma unroll
    for (int r = 0; r < 4; ++r) {
      float mu = 0.f, mv = 0.f;
#pragma unroll
      for (int q = 0; q < 4; ++q) {
        a[r][q].x *= g[q].x; a[r][q].y *= g[q].y; a[r][q].z *= g[q].z; a[r][q].w *= g[q].w;
        mu = fmaxf(fmaxf(fmaxf(mu, fabsf(a[r][q].x)), fabsf(a[r][q].y)), fmaxf(fabsf(a[r][q].z), fabsf(a[r][q].w)));
        mv = fmaxf(fmaxf(fmaxf(mv, fabsf(c[r][q].x)), fabsf(c[r][q].y)), fmaxf(fabsf(c[r][q].z), fabsf(c[r][q].w)));
      }
      mu = wave_max_pos(mu); mv = wave_max_pos(mv);
      const float iu = mu > 0.f ? 6.f / mu : 0.f, iv = mv > 0.f ? 6.f / mv : 0.f;
#pragma unroll
      for (int q = 0; q < 4; ++q) {
        u4[(row0 + r) * 256 + lane + 64 * q] = (u16)pack_fp4x4(a[r][q], iu);
        v4[(row0 + r) * 256 + lane + 64 * q] = (u16)pack_fp4x4(c[r][q], iv);
      }
      if (lane == 0) { rsu[row0 + r] = mu * (1.f / 6.f); rsv[row0 + r] = mv * (1.f / 6.f); }
    }
  }
}
constexpr int Q2_WORD = 3600;
DI void phase2(const Params& p, int bid, int nb, int tid, char* smem, int mode = 3) {
  (void)bid; (void)nb;
  unsigned* qh = (unsigned*)(p.ws + OFF_BAR) + Q2_WORD + 64 * (mode >> 2);
  mode &= 3;
  volatile int* s_item = (volatile int*)(smem + 32);
  for (;;) {
    __syncthreads();
    if (tid == 0) *s_item = (int)__hip_atomic_fetch_add(qh, 1u, __ATOMIC_RELAXED, __HIP_MEMORY_SCOPE_AGENT);
    __syncthreads();
    const int item = *s_item;
    if (item >= 576) break;
    if (item < 64) { if (mode & 1) mlstm_scan(p, item, smem, tid); }
    else if (((item - 64) & 1) == 0) { if (mode & 2) mla_prep(p, (item - 64) >> 1, smem, tid); }
    else { if (mode == 3) tables_fp8_chunk(p, (item - 64) >> 1, tid); }
  }
}

constexpr int A_KP = 400, A_VP = 72, A_KB = 32 * A_KP, A_VB = 128 * A_VP, A_SB = A_KB + A_VB;
DI void attn_qblock(const Params& p, int bh, int qb, char* smem, int tid) {
  char* ws = p.ws;
  char* base = smem + 1024;
  const int w = tid >> 6, lane = tid & 63, r = lane & 31, h = lane >> 5;
  const int rg = w & 3, ksp = w >> 2;
  const int qrow = 128 * qb + 32 * rg + r;
  const u16* Kg = (const u16*)(ws + OFF_K) + (size_t)bh * 4096 * 192;
  const u16* Vg = (const u16*)(ws + OFF_VTA) + (size_t)bh * 128 * 4096;
  bf16x8 qf[12];
  {
    const u16* qp = (const u16*)(ws + OFF_Q) + ((size_t)bh * 4096 + qrow) * 192 + 8 * h;
#pragma unroll
    for (int ks = 0; ks < 12; ++ks) qf[ks] = *(const bf16x8*)(qp + 16 * ks);
  }
  f32x16 O[4];
#pragma unroll
  for (int i = 0; i < 4; ++i) O[i] = zero16();
  float mrun = -1e30f, lrun = 0.f;
  const int nsteps = 2 * (qb + 1);
  const int lastkt = 4 * qb + rg;
  const int krow = tid >> 3, kch = tid & 7;
  const unsigned ksrc0 = (unsigned)((krow * 192 + 8 * kch) * 2);
  const int kdst0 = (krow >> 5) * A_SB + (krow & 31) * A_KP + kch * 16;
  const unsigned vsrc0 = (unsigned)(((tid >> 2) * 4096 + 8 * (tid & 3)) * 2);
  const int vdst0 = A_KB + (tid >> 2) * A_VP + (tid & 3) * 16;
#define A_ISSUEK(KR, step) do { \
      _Pragma("unroll") for (int e = 0; e < 3; ++e) KR[e] = *(const i32x4*)((const char*)Kg + (ksrc0 + (unsigned)((step) * 64 * 192 * 2 + e * 128))); } while (0)
#define A_ISSUEV(VR, step) do { \
      _Pragma("unroll") for (int e = 0; e < 2; ++e) VR[e] = *(const i32x4*)((const char*)Vg + (vsrc0 + (unsigned)((step) * 128 + e * 64))); } while (0)
#define A_WRITEK(KR, st) do { char* sb_ = base + (st) * 2 * A_SB; \
      _Pragma("unroll") for (int e = 0; e < 3; ++e) *(i32x4*)(sb_ + kdst0 + e * 128) = KR[e]; } while (0)
#define A_WRITEV(VR, st) do { char* sb_ = base + (st) * 2 * A_SB; \
      _Pragma("unroll") for (int e = 0; e < 2; ++e) { *(uint2*)(sb_ + vdst0 + e * A_SB) = make_uint2((unsigned)VR[e][0], (unsigned)VR[e][1]); \
        *(uint2*)(sb_ + vdst0 + e * A_SB + 8) = make_uint2((unsigned)VR[e][2], (unsigned)VR[e][3]); } } while (0)
  auto compute = [&](int i, int st) {
    const int kt = 2 * i + ksp;
    if (kt <= lastkt) {
      const char* kb = base + (st * 2 + ksp) * A_SB;
      const char* vbuf = kb + A_KB;
      f32x16 S = zero16();
#pragma unroll
      for (int ks = 0; ks < 12; ++ks) {
        const bf16x8 a = *(const bf16x8*)(kb + r * A_KP + (16 * ks + 8 * h) * 2);
        S = MFMA32(a, qf[ks], S);
      }
      if (kt == lastkt) {
#pragma unroll
        for (int i2 = 0; i2 < 16; ++i2) if (crow(i2, h) > r) S[i2] = -1e30f;
      }
      float mx = S[0];
#pragma unroll
      for (int i2 = 1; i2 < 16; ++i2) mx = fmaxf(mx, S[i2]);
      mx = fmaxf(mx, __shfl_xor(mx, 32));
      const float mnew = fmaxf(mrun, mx);
      float ps = 0.f;
#pragma unroll
      for (int i2 = 0; i2 < 16; ++i2) { S[i2] = __builtin_amdgcn_exp2f(S[i2] - mnew); ps += S[i2]; }
      if (__any(mnew > mrun)) {
        const float alpha = __builtin_amdgcn_exp2f(mrun - mnew);
        lrun *= alpha;
#pragma unroll
        for (int d = 0; d < 4; ++d)
#pragma unroll
          for (int i2 = 0; i2 < 16; ++i2) O[d][i2] *= alpha;
      }
      mrun = mnew;
      lrun += ps;
#pragma unroll
      for (int s2 = 0; s2 < 2; ++s2) {
        i32x4 pw;
#pragma unroll
        for (int j = 0; j < 4; ++j) pw[j] = (int)pk2(S[8 * s2 + 2 * j], S[8 * s2 + 2 * j + 1]);
        const bf16x8 pb = __builtin_bit_cast(bf16x8, pw);
#pragma unroll
        for (int d = 0; d < 4; ++d) {
          const char* va = vbuf + (32 * d + r) * A_VP + (16 * s2 + 4 * h) * 2;
          const uint2 lo = *(const uint2*)va, hi = *(const uint2*)(va + 16);
          i32x4 av = {(int)lo.x, (int)lo.y, (int)hi.x, (int)hi.y};
          O[d] = MFMA32(__builtin_bit_cast(bf16x8, av), pb, O[d]);
        }
      }
    }
  };
  i32x4 kX[3], kY[3], vR[2];
  A_ISSUEK(kX, 0); A_ISSUEV(vR, 0); A_WRITEK(kX, 0); A_WRITEV(vR, 0);
  __syncthreads();
  A_ISSUEK(kX, 1);
  for (int i = 0; i < nsteps; i += 2) {
    if (i + 2 < nsteps) A_ISSUEK(kY, i + 2);
    A_ISSUEV(vR, i + 1);
    compute(i, 0);
    A_WRITEK(kX, 1); A_WRITEV(vR, 1);
    __syncthreads();
    if (i + 3 < nsteps) A_ISSUEK(kX, i + 3);
    if (i + 2 < nsteps) A_ISSUEV(vR, i + 2);
    compute(i + 1, 1);
    if (i + 2 < nsteps) { A_WRITEK(kY, 0); A_WRITEV(vR, 0); }
    __syncthreads();
  }
#undef A_ISSUEK
#undef A_ISSUEV
#undef A_WRITEK
#undef A_WRITEV
  lrun += __shfl_xor(lrun, 32);
  float* cb = (float*)base + (size_t)rg * 66 * 64;
  if (ksp == 1) {
    cb[lane] = mrun; cb[64 + lane] = lrun;
#pragma unroll
    for (int d = 0; d < 4; ++d)
#pragma unroll
      for (int i2 = 0; i2 < 16; ++i2) cb[(2 + d * 16 + i2) * 64 + lane] = O[d][i2];
  }
  __syncthreads();
  if (ksp == 0) {
    const float m1 = cb[lane], l1 = cb[64 + lane];
    const float mt = fmaxf(mrun, m1);
    const float a0 = __builtin_amdgcn_exp2f(mrun - mt), a1 = __builtin_amdgcn_exp2f(m1 - mt);
    const float inv = 1.f / (lrun * a0 + l1 * a1);
    const int hd = bh & 3, b = bh >> 2;
    u16* mo = (u16*)(ws + OFF_MIX) + ((size_t)b * 4096 + qrow) * 1024 + 512 + hd * 128;
#pragma unroll
    for (int d = 0; d < 4; ++d)
#pragma unroll
      for (int g = 0; g < 4; ++g) {
        float o[4];
#pragma unroll
        for (int q = 0; q < 4; ++q) o[q] = (O[d][4 * g + q] * a0 + cb[(2 + d * 16 + 4 * g + q) * 64 + lane] * a1) * inv;
        *(uint2*)(mo + 32 * d + 8 * g + 4 * h) = pk4(o[0], o[1], o[2], o[3]);
      }
  }
  __syncthreads();
}

DI void mlstm_out(const Params& p, int item, char* smem, int tid) {
  asm volatile("" : "+v"(tid));
  char* ws = p.ws;
  const int bh = item >> 6, c = item & 63, b = bh >> 2, hd = bh & 3;
  float* s_b = (float*)(smem + 1024);
  float* s_u = s_b + 64;
  float* s_M = s_u + 64;
  float* s_n = s_M + 64;
  float* s_ss = s_n + 128;
  const float mc = ((const float*)(ws + OFF_MST))[bh * 64 + c];
  const size_t t0 = (size_t)b * 4096 + 64 * c;
  const int w = tid >> 6, lane = tid & 63, r = lane & 31, h = lane >> 5;
  const int tt = w & 1, dt = w >> 1;
  const int tl = 32 * tt + r;
  const size_t tg = t0 + tl;
  const u16* qp = (const u16*)(ws + OFF_QM) + tg * 512 + hd * 128 + 8 * h;
  const u16* kp = (const u16*)(ws + OFF_KM) + (t0 + r) * 512 + hd * 128 + 8 * h;
  const u16* vp = (const u16*)(ws + OFF_VT) + ((size_t)bh * 128 + 32 * dt + r) * 4096 + 64 * c + 4 * h;
  const u16* cp = (const u16*)(ws + OFF_CST) + ((size_t)bh * 64 + c) * 16384 + (size_t)(32 * dt + r) * 128 + 8 * h;
  const u16* op = (const u16*)(ws + OFF_OM) + tg * 512 + hd * 128 + 32 * dt;
  bf16x8 qf[8], kf[2][8], cf[8];
  uint2 vlo[2][2], vhi[2][2], ov[4];
#pragma unroll
  for (int ks = 0; ks < 8; ++ks) qf[ks] = *(const bf16x8*)(qp + 16 * ks);
#pragma unroll
  for (int st = 0; st < 2; ++st)
#pragma unroll
    for (int ks = 0; ks < 8; ++ks) kf[st][ks] = *(const bf16x8*)(kp + (size_t)st * 32 * 512 + 16 * ks);
#pragma unroll
  for (int st = 0; st < 2; ++st)
#pragma unroll
    for (int s2 = 0; s2 < 2; ++s2) { vlo[st][s2] = *(const uint2*)(vp + 32 * st + 16 * s2); vhi[st][s2] = *(const uint2*)(vp + 32 * st + 16 * s2 + 8); }
#pragma unroll
  for (int ks = 0; ks < 8; ++ks) cf[ks] = *(const bf16x8*)(cp + 16 * ks);
#pragma unroll
  for (int g = 0; g < 4; ++g) ov[g] = *(const uint2*)(op + 8 * g + 4 * h);
  if (tid < 64) {
    const float lf = logsig(((const float*)(ws + OFF_GF))[(t0 + tid) * 4 + hd] + p.b_f[hd]);
    const float ip = ((const float*)(ws + OFF_GI))[(t0 + tid) * 4 + hd] + p.b_i[hd];
    float bc = lf;
#pragma unroll
    for (int o = 1; o < 64; o <<= 1) { const float t2 = __shfl_up(bc, o); if (tid >= o) bc += t2; }
    const float u = ip - bc;
    float pm = u;
#pragma unroll
    for (int o = 1; o < 64; o <<= 1) { const float t2 = __shfl_up(pm, o); if (tid >= o) pm = fmaxf(pm, t2); }
    s_b[tid] = bc; s_u[tid] = u; s_M[tid] = fmaxf(mc, pm);
  } else if (tid < 192) {
    s_n[tid - 64] = ((const float*)(ws + OFF_NST))[((size_t)bh * 64 + c) * 128 + (tid - 64)];
  }
  __syncthreads();
  float qn = 0.f;
#pragma unroll
  for (int ks = 0; ks < 8; ++ks)
#pragma unroll
    for (int j = 0; j < 8; ++j) qn = fmaf(bf2f(qf[ks][j]), s_n[16 * ks + 8 * h + j], qn);
  qn += __shfl_xor(qn, 32);
  const float Mt = s_M[tl], bt = s_b[tl];
  const float aw = __expf(mc - Mt);
  f32x16 H1 = zero16(), H2 = zero16();
  float psum = 0.f;
#pragma unroll
  for (int st = 0; st < 2; ++st) {
    f32x16 S = zero16();
#pragma unroll
    for (int ks = 0; ks < 8; ++ks) S = MFMA32(kf[st][ks], qf[ks], S);
#pragma unroll
    for (int i = 0; i < 16; ++i) {
      const int sl = 32 * st + crow(i, h);
      const float wgt = (sl <= tl) ? __expf(s_u[sl] - Mt) : 0.f;
      S[i] *= wgt; psum += S[i];
    }
#pragma unroll
    for (int s2 = 0; s2 < 2; ++s2) {
      i32x4 pw;
#pragma unroll
      for (int j = 0; j < 4; ++j) pw[j] = (int)pk2(S[8 * s2 + 2 * j], S[8 * s2 + 2 * j + 1]);
      i32x4 av = {(int)vlo[st][s2].x, (int)vlo[st][s2].y, (int)vhi[st][s2].x, (int)vhi[st][s2].y};
      H1 = MFMA32(__builtin_bit_cast(bf16x8, av), __builtin_bit_cast(bf16x8, pw), H1);
    }
  }
  psum += __shfl_xor(psum, 32);
#pragma unroll
  for (int ks = 0; ks < 8; ++ks) H2 = MFMA32(cf[ks], qf[ks], H2);
  const float den = aw * qn + psum;
  const float dinv = 1.f / fmaxf(fabsf(den), __expf(-(bt + Mt)));
  float hv[16]; float ss = 0.f;
#pragma unroll
  for (int i = 0; i < 16; ++i) { hv[i] = (H1[i] + aw * H2[i]) * dinv; ss = fmaf(hv[i], hv[i], ss); }
  ss += __shfl_xor(ss, 32);
  if (h == 0) s_ss[dt * 64 + tl] = ss;
  __syncthreads();
  const float tot = s_ss[tl] + s_ss[64 + tl] + s_ss[128 + tl] + s_ss[192 + tl];
  const float rstd = rsqrtf(tot * (1.f / 128.f) + EPS);
  u16* yo = (u16*)(ws + OFF_MIX) + tg * 1024 + hd * 128 + 32 * dt;
  float4 ggv[4];
#pragma unroll
  for (int g = 0; g < 4; ++g) ggv[g] = *(const float4*)(p.mn_g + hd * 128 + 32 * dt + 8 * g + 4 * h);
#pragma unroll
  for (int g = 0; g < 4; ++g) {
    const int d0 = 8 * g + 4 * h;
    const float og[4] = {bf2f((short)(ov[g].x & 0xffff)), bf2f((short)(ov[g].x >> 16)), bf2f((short)(ov[g].y & 0xffff)), bf2f((short)(ov[g].y >> 16))};
    const float4 gg = ggv[g];
    const float ga[4] = {gg.x, gg.y, gg.z, gg.w};
    float y[4];
#pragma unroll
    for (int q = 0; q < 4; ++q) y[q] = hv[4 * g + q] * rstd * ga[q] / (1.f + __expf(-og[q]));
    *(uint2*)(yo + d0) = pk4(y[0], y[1], y[2], y[3]);
  }
  __syncthreads();
}

DI void phase3(const Params& p, int bid, int nb, int tid, char* smem, int mode = 3) {
  if (mode & 1) for (int item = bid; item < 256; item += nb) {
    const int bh = ((item & 7) << 1) | ((item >> 7) & 1), pp = (item >> 3) & 15;
    attn_qblock(p, bh, pp, smem, tid);
    attn_qblock(p, bh, 31 - pp, smem, tid);
  }
  if (mode & 2) for (int item = bid; item < 1024; item += nb) mlstm_out(p, item, smem, tid);
}

DI void phase4(const Params& p, int bid, int nb, int tid, char* smem) {
  char* ws = p.ws;
  const int nunits = 64 * 4;
  for (int u = bid; u < nunits; u += nb) {
    const int v = xcd_unit(u, nunits), pm = v / 4, pn = v % 4;
    float rs[8][4];
    const char* xb = (const char*)p.x;
    float xv[4][4];
    auto pre = [&](int, int ni, int r0, int c) {
#pragma unroll
      for (int j = 0; j < 4; ++j) xv[ni][j] = *(const float*)(xb + ((unsigned)(r0 + j) * 1024u + (unsigned)c) * 4u);
    };
    auto epi = [&](int mi, int ni, int r0, int c, f32x4 a) {
#pragma unroll
      for (int j = 0; j < 4; ++j) {
        const unsigned o = (unsigned)(r0 + j) * 1024u + (unsigned)c;
        const float y = xv[ni][j] + a[j];
        *(u16*)(ws + ((unsigned)OFF_X1B + o * 2u)) = f2bf(y);
        if (ni == 0) rs[mi][j] = y * y; else rs[mi][j] = fmaf(y, y, rs[mi][j]);
      }
    };
    gemm_tile8((const u16*)(ws + OFF_MIX), (const u16*)(ws + OFF_WOUT), 1024, pm * 256, pn * 256, smem, epi, pre);
    int tz = tid; asm volatile("" : "+v"(tz));
    const int wid = tz >> 6, lane = tz & 63, wc = wid & 3, wr = wid >> 2, fr = lane & 15, fq = lane >> 4;
#pragma unroll
    for (int mi = 0; mi < 8; ++mi)
#pragma unroll
      for (int j = 0; j < 4; ++j) {
        float s = rs[mi][j];
        s += __shfl_xor(s, 1); s += __shfl_xor(s, 2); s += __shfl_xor(s, 4); s += __shfl_xor(s, 8);
        if (fr == 0) *(float*)(ws + ((unsigned)OFF_SSQ + ((unsigned)(pm * 256 + (mi >> 2) * 128 + wr * 64 + (mi & 3) * 16 + fq * 4 + j) * 16u + (unsigned)(pn * 4 + wc)) * 4u)) = s;
      }
  }
}

DI void peer_topk_tile(const Params& p, const char* tile, int t0, int hd, int wv, int lane);
DI void phase5(const Params& p, int bid, int nb, int tid, char* smem) {
  char* ws = p.ws;
  const int nunits = 64 * 8;
  float* s_rstd = (float*)(smem + 1024);
  for (int u = bid; u < nunits; u += nb) {
    const int v = xcd_unit(u, nunits), pm = v / 8, pn = v % 8;
    __syncthreads();
    if (tid < 256) {
      const float4* sp = (const float4*)((const float*)(ws + OFF_SSQ) + (size_t)(pm * 256 + tid) * 16);
      float s = 0.f;
#pragma unroll
      for (int i = 0; i < 4; ++i) { const float4 a = sp[i]; s += a.x + a.y + a.z + a.w; }
      s_rstd[tid] = rsqrtf(s * (1.f / 1024.f) + EPS);
    }
    __syncthreads();
    char* tile = smem + LDS_GEMM_OFF;
    auto epi = [&](int, int, int r0, int c, f32x4 a) {
      const int cl = c - pn * 256;
#pragma unroll
      for (int j = 0; j < 4; ++j) {
        const int rl = r0 + j - pm * 256;
        *(u16*)(tile + rl * 512 + ((((cl >> 3) ^ (rl & 31)) << 4) | ((cl & 7) << 1))) = f2bf(a[j] * s_rstd[rl]);
      }
    };
    gemm_tile8((const u16*)(ws + OFF_X1B), (const u16*)(ws + OFF_WPQ), 1024, pm * 256, pn * 256, smem, epi);
    peer_topk_tile(p, tile, pm * 256, pn, __builtin_amdgcn_readfirstlane(tid >> 6), tid & 63);
  }
}

DI void ins16(float (&L)[16], float v) {
#pragma unroll
  for (int j = 15; j >= 1; --j) L[j] = __builtin_amdgcn_fmed3f(L[j - 1], L[j], v);
  L[0] = fmaxf(L[0], v);
}
DI void top16_side(const u16* __restrict__ keys, const u16* __restrict__ qrow, int r, int h, float (&L)[16]) {
  f32x16 acc[4];
#pragma unroll
  for (int i = 0; i < 4; ++i) acc[i] = zero16();
#pragma unroll 2
  for (int ks = 0; ks < 8; ++ks) {
    const bf16x8 bq = *(const bf16x8*)(qrow + 16 * ks + 8 * h);
#pragma unroll
    for (int kt = 0; kt < 4; ++kt) {
      const bf16x8 a = *(const bf16x8*)(keys + (size_t)(32 * kt + r) * 128 + 16 * ks + 8 * h);
      acc[kt] = MFMA32(a, bq, acc[kt]);
    }
  }
#pragma unroll
  for (int j = 0; j < 16; ++j) L[j] = -3.0e38f;
#pragma unroll
  for (int kt = 0; kt < 4; ++kt)
#pragma unroll
    for (int i = 0; i < 16; ++i) {
      const unsigned idx = 32 * kt + crow(i, h);
      const float v = __uint_as_float((__float_as_uint(acc[kt][i]) & ~127u) | idx);
      ins16(L, v);
    }
  float P[16];
#pragma unroll
  for (int j = 0; j < 16; ++j) P[j] = __shfl_xor(L[j], 32);
#pragma unroll
  for (int j = 0; j < 16; ++j) ins16(L, P[j]);
}
#define CE16(i, j) do { const float hi_ = fmaxf(a[i], a[j]), lo_ = fminf(a[i], a[j]); a[i] = hi_; a[j] = lo_; } while (0)
DI void sort16_desc(float (&a)[16]) {
  CE16(0, 1);
  CE16(2, 3);
  CE16(0, 2);
  CE16(1, 3);
  CE16(1, 2);
  CE16(4, 5);
  CE16(6, 7);
  CE16(4, 6);
  CE16(5, 7);
  CE16(5, 6);
  CE16(0, 4);
  CE16(2, 6);
  CE16(2, 4);
  CE16(1, 5);
  CE16(3, 7);
  CE16(3, 5);
  CE16(1, 2);
  CE16(3, 4);
  CE16(5, 6);
  CE16(8, 9);
  CE16(10, 11);
  CE16(8, 10);
  CE16(9, 11);
  CE16(9, 10);
  CE16(12, 13);
  CE16(14, 15);
  CE16(12, 14);
  CE16(13, 15);
  CE16(13, 14);
  CE16(8, 12);
  CE16(10, 14);
  CE16(10, 12);
  CE16(9, 13);
  CE16(11, 15);
  CE16(11, 13);
  CE16(9, 10);
  CE16(11, 12);
  CE16(13, 14);
  CE16(0, 8);
  CE16(4, 12);
  CE16(4, 8);
  CE16(2, 10);
  CE16(6, 14);
  CE16(6, 10);
  CE16(2, 4);
  CE16(6, 8);
  CE16(10, 12);
  CE16(1, 9);
  CE16(5, 13);
  CE16(5, 9);
  CE16(3, 11);
  CE16(7, 15);
  CE16(7, 11);
  CE16(3, 5);
  CE16(7, 9);
  CE16(11, 13);
  CE16(1, 2);
  CE16(3, 4);
  CE16(5, 6);
  CE16(7, 8);
  CE16(9, 10);
  CE16(11, 12);
  CE16(13, 14);
}
DI void merge_top16(float (&a)[16], const float (&b)[16]) {
#pragma unroll
  for (int i = 0; i < 16; ++i) a[i] = fmaxf(a[i], b[15 - i]);
#pragma unroll
  for (int s = 8; s >= 1; s >>= 1)
#pragma unroll
    for (int i = 0; i < 16; ++i)
      if ((i & s) == 0) CE16(i, i + s);
}
DI const bf16x8* qt_chunk(const char* tile, int row, int chunk) { return (const bf16x8*)(tile + row * 512 + ((chunk ^ (row & 31)) << 4)); }
DI void top16_side_lds(const u16* __restrict__ keys_, const char* tile, int row, int side, int r, int h, float (&L)[16]) {
  const char* keys = (const char*)keys_;
  const unsigned koff = ((unsigned)r * 128u + 8u * (unsigned)h) * 2u;
  f32x16 acc[4];
#pragma unroll
  for (int i = 0; i < 4; ++i) acc[i] = zero16();
#pragma unroll 2
  for (int ks = 0; ks < 8; ++ks) {
    const bf16x8 bq = *qt_chunk(tile, row, side * 16 + 2 * ks + h);
#pragma unroll
    for (int kt = 0; kt < 4; ++kt) {
      const bf16x8 a = *(const bf16x8*)(keys + (koff + (unsigned)((32 * kt * 128 + 16 * ks) * 2)));
      acc[kt] = MFMA32(a, bq, acc[kt]);
    }
  }
  float G[4][16];
#pragma unroll
  for (int kt = 0; kt < 4; ++kt) {
#pragma unroll
    for (int i = 0; i < 16; ++i) {
      const unsigned idx = 32 * kt + crow(i, h);
      G[kt][i] = __uint_as_float((__float_as_uint(acc[kt][i]) & ~127u) | idx);
    }
    sort16_desc(G[kt]);
  }
  merge_top16(G[0], G[1]); merge_top16(G[2], G[3]); merge_top16(G[0], G[2]);
  float P[16];
#pragma unroll
  for (int j = 0; j < 16; ++j) P[j] = __shfl_xor(G[0][j], 32);
  merge_top16(G[0], P);
#pragma unroll
  for (int j = 0; j < 16; ++j) L[j] = G[0][j];
}
DI void peer_topk_tile(const Params& p, const char* tile, int t0, int hd, int wv, int lane) {
  asm volatile("" : "+v"(lane));
  char* ws = p.ws;
  const int r = lane & 31, h = lane >> 5;
  const int row = 32 * wv + r, t = t0 + row;
  float L1[16], L2[16];
  top16_side_lds((const u16*)(ws + OFF_K1), tile, row, 0, r, h, L1);
  top16_side_lds((const u16*)(ws + OFF_K2), tile, row, 1, r, h, L2);
  float Lc[16];
#pragma unroll
  for (int j = 0; j < 16; ++j) Lc[j] = -3.0e38f;
#pragma unroll
  for (int i = 0; i < 16; ++i)
#pragma unroll
    for (int j = 0; j < 16; ++j)
      if ((i + 1) * (j + 1) <= 16) ins16(Lc, L1[i] + L2[j]);
  const float th = Lc[15], mx = Lc[0];
  float sum = 0.f;
#pragma unroll
  for (int j = 0; j < 16; ++j) sum += __expf(Lc[j] - mx);
  const float isum = 1.f / sum;
  unsigned* sel = (unsigned*)(ws + OFF_SEL) + (size_t)t * 128 + hd * 16;
  int cnt = 0, pidx = 0;
#pragma unroll
  for (int i = 0; i < 16; ++i)
#pragma unroll
    for (int j = 0; j < 16; ++j)
      if ((i + 1) * (j + 1) <= 16) {
        const float c = L1[i] + L2[j];
        if (c >= th) {
          if (cnt < 16 && ((pidx & 1) == h)) {
            const unsigned idx = (__float_as_uint(L1[i]) & 127u) * 128u + (__float_as_uint(L2[j]) & 127u);
            sel[cnt] = (idx << 18) | ((__float_as_uint(__expf(c - mx) * isum) >> 13) & 0x3FFFFu);
          }
          ++cnt;
        }
        ++pidx;
      }
}
DI void peer_topk(const Params& p, int witem, int lane) {
  char* ws = p.ws;
  const int r = lane & 31, h = lane >> 5;
  const int hd = witem & 7, tb = witem >> 3;
  const int t = tb * 32 + r;
  const u16* qrow = (const u16*)(ws + OFF_QRY) + (size_t)t * 2048 + hd * 256;
  float L1[16], L2[16];
  top16_side((const u16*)(ws + OFF_K1), qrow, r, h, L1);
  top16_side((const u16*)(ws + OFF_K2), qrow + 128, r, h, L2);
  float Lc[16];
#pragma unroll
  for (int j = 0; j < 16; ++j) Lc[j] = -3.0e38f;
#pragma unroll
  for (int i = 0; i < 16; ++i)
#pragma unroll
    for (int j = 0; j < 16; ++j)
      if ((i + 1) * (j + 1) <= 16) ins16(Lc, L1[i] + L2[j]);
  const float th = Lc[15], mx = Lc[0];
  float sum = 0.f;
#pragma unroll
  for (int j = 0; j < 16; ++j) sum += __expf(Lc[j] - mx);
  const float isum = 1.f / sum;
  unsigned* sel = (unsigned*)(ws + OFF_SEL) + (size_t)t * 128 + hd * 16;
  int cnt = 0, pidx = 0;
#pragma unroll
  for (int i = 0; i < 16; ++i)
#pragma unroll
    for (int j = 0; j < 16; ++j)
      if ((i + 1) * (j + 1) <= 16) {
        const float c = L1[i] + L2[j];
        if (c >= th) {
          if (cnt < 16 && ((pidx & 1) == h)) {
            const unsigned idx = (__float_as_uint(L1[i]) & 127u) * 128u + (__float_as_uint(L2[j]) & 127u);
            sel[cnt] = (idx << 18) | ((__float_as_uint(__expf(c - mx) * isum) >> 13) & 0x3FFFFu);
          }
          ++cnt;
        }
        ++pidx;
      }
}
DI void phase6(const Params& p, int bid, int nb, int tid) {
  const int gw = bid * 8 + (tid >> 6), nw = nb * 8;
  for (int wi = gw; wi < 4096; wi += nw) peer_topk(p, wi, tid & 63);
}

template <int CTRL, int RM>
DI float dpp_add(float v) { return v + __int_as_float(__builtin_amdgcn_update_dpp(0, __float_as_int(v), CTRL, RM, 0xF, false)); }
DI float wave_total(float v) {
  v = dpp_add<0xB1, 0xF>(v);
  v = dpp_add<0x4E, 0xF>(v);
  v = dpp_add<0x141, 0xF>(v);
  v = dpp_add<0x140, 0xF>(v);
  v = dpp_add<0x142, 0xA>(v);
  v = dpp_add<0x143, 0xC>(v);
  return __int_as_float(__builtin_amdgcn_readlane(__float_as_int(v), 63));
}
DI void sort128(unsigned& a0, unsigned& a1, int lane) {
#pragma unroll
  for (int k = 2; k <= 128; k <<= 1) {
#pragma unroll
    for (int j = k >> 1; j > 0; j >>= 1) {
      if (j == 64) {
        const unsigned lo = min(a0, a1), hi = max(a0, a1);
        a0 = lo; a1 = hi;
      } else {
        const int pa = (lane ^ j) << 2;
        const unsigned o0 = (unsigned)__builtin_amdgcn_ds_bpermute(pa, (int)a0), o1 = (unsigned)__builtin_amdgcn_ds_bpermute(pa, (int)a1);
        const bool lowpos = (lane & j) == 0;
        const bool asc0 = (k == 128) ? true : ((lane & k) == 0);
        const bool asc1 = (k == 128) ? true : (k == 64 ? false : ((lane & k) == 0));
        a0 = (asc0 == lowpos) ? min(a0, o0) : max(a0, o0);
        a1 = (asc1 == lowpos) ? min(a1, o1) : max(a1, o1);
      }
    }
  }
}
template <int J>
DI unsigned sort_partner(unsigned v, int pa) {
  if (J == 1) return (unsigned)__builtin_amdgcn_update_dpp(0, (int)v, 0xB1, 0xF, 0xF, false);
  if (J == 2) return (unsigned)__builtin_amdgcn_update_dpp(0, (int)v, 0x4E, 0xF, 0xF, false);
  if (J == 8) return (unsigned)__builtin_amdgcn_update_dpp(0, (int)v, 0x128, 0xF, 0xF, false);
  return (unsigned)__builtin_amdgcn_ds_bpermute(pa, (int)v);
}
template <int K, int J>
DI void sort_stage8(unsigned (&a)[8][2], int lane) {
  if (J == 64) {
#pragma unroll
    for (int t = 0; t < 8; ++t) { const unsigned lo = min(a[t][0], a[t][1]), hi = max(a[t][0], a[t][1]); a[t][0] = lo; a[t][1] = hi; }
  } else {
    const int pa = (lane ^ J) << 2;
    unsigned o[8][2];
#pragma unroll
    for (int t = 0; t < 8; ++t) { o[t][0] = sort_partner<J>(a[t][0], pa); o[t][1] = sort_partner<J>(a[t][1], pa); }
    const bool lowpos = (lane & J) == 0;
    const bool asc0 = (K == 128) ? true : ((lane & K) == 0);
    const bool asc1 = (K == 128) ? true : (K == 64 ? false : ((lane & K) == 0));
#pragma unroll
    for (int t = 0; t < 8; ++t) {
      a[t][0] = (asc0 == lowpos) ? min(a[t][0], o[t][0]) : max(a[t][0], o[t][0]);
      a[t][1] = (asc1 == lowpos) ? min(a[t][1], o[t][1]) : max(a[t][1], o[t][1]);
    }
  }
}
template <int K, int J>
DI void sort_merge8(unsigned (&a)[8][2], int lane) { sort_stage8<K, J>(a, lane); if constexpr (J > 1) sort_merge8<K, J / 2>(a, lane); }
template <int K>
DI void sort_all8(unsigned (&a)[8][2], int lane) { if constexpr (K > 2) sort_all8<K / 2>(a, lane); sort_merge8<K, K / 2>(a, lane); }
DI void cvt16(const uint4 r, float (&f)[16]) {
  const unsigned w[4] = {r.x, r.y, r.z, r.w};
#pragma unroll
  for (int i = 0; i < 4; ++i) {
    const f32x2 lo = __builtin_amdgcn_cvt_pk_f32_fp8((int)w[i], false), hi = __builtin_amdgcn_cvt_pk_f32_fp8((int)w[i], true);
    f[4 * i] = lo[0]; f[4 * i + 1] = lo[1]; f[4 * i + 2] = hi[0]; f[4 * i + 3] = hi[1];
  }
}
constexpr int P7_WLDS = 16384;
constexpr int P7_IMG = 2048, P7_DOT = 10752, P7_C8 = 14848, P7_INV = 15872;
DI long lo64v(u32x4 v) { return (long)(((unsigned long long)v[1] << 32) | v[0]); }
DI long hi64v(u32x4 v) { return (long)(((unsigned long long)v[3] << 32) | v[2]); }
DI long lo64(const uint4& v) { return (long)(((unsigned long long)v.y << 32) | v.x); }
DI long hi64(const uint4& v) { return (long)(((unsigned long long)v.w << 32) | v.z); }
#define VW_LOAD(dst, ptr) asm volatile("global_load_dwordx2 %0, %1, off" : "=v"(dst) : "v"(ptr) : "memory")
#define VW_WAIT(n, a, b, c, d) asm volatile("s_waitcnt vmcnt(" #n ")" : "+v"(a), "+v"(b), "+v"(c), "+v"(d) :: "memory")
template <int TPW>
DI void peer_vwalk(const Params& p, int t0, int lane, const unsigned (&pk)[TPW][2], const float (&coef)[TPW][2], bool do_store) {
  static_assert(TPW == 4, "4 tokens per sub-round");
  char* ws = p.ws;
  const unsigned char* V = (const unsigned char*)(ws + OFF_V8) + 8 * lane;
  float y[TPW][16];
#pragma unroll
  for (int k = 0; k < TPW; ++k)
#pragma unroll
    for (int j = 0; j < 16; ++j) y[k][j] = 0.f;
  auto comp = [&](const u32x2& r0, const u32x2& r1, const u32x2& r2, const u32x2& r3, const float (&cf)[4], int pos) {
    const u32x2 rr[4] = {r0, r1, r2, r3};
#pragma unroll
    for (int k = 0; k < 4; ++k) {
      const float c = __int_as_float(__builtin_amdgcn_readlane(__float_as_int(cf[k]), pos));
#pragma unroll
      for (int i = 0; i < 2; ++i) {
        const f32x2 e0 = __builtin_amdgcn_cvt_scalef32_pk_f32_fp4(rr[k][i], 1.0f, 0), e1 = __builtin_amdgcn_cvt_scalef32_pk_f32_fp4(rr[k][i], 1.0f, 1);
        const f32x2 e2 = __builtin_amdgcn_cvt_scalef32_pk_f32_fp4(rr[k][i], 1.0f, 2), e3 = __builtin_amdgcn_cvt_scalef32_pk_f32_fp4(rr[k][i], 1.0f, 3);
        y[k][8 * i] = fmaf(c, e0[0], y[k][8 * i]); y[k][8 * i + 1] = fmaf(c, e0[1], y[k][8 * i + 1]);
        y[k][8 * i + 2] = fmaf(c, e1[0], y[k][8 * i + 2]); y[k][8 * i + 3] = fmaf(c, e1[1], y[k][8 * i + 3]);
        y[k][8 * i + 4] = fmaf(c, e2[0], y[k][8 * i + 4]); y[k][8 * i + 5] = fmaf(c, e2[1], y[k][8 * i + 5]);
        y[k][8 * i + 6] = fmaf(c, e3[0], y[k][8 * i + 6]); y[k][8 * i + 7] = fmaf(c, e3[1], y[k][8 * i + 7]);
      }
    }
  };
#define VW_ROWP(arr, k, pos) (V + (size_t)(((unsigned)__builtin_amdgcn_readlane((int)arr[k], pos)) >> 18) * 512)
#define VW_LOAD4(x0, x1, x2, x3, arr, pos) do { VW_LOAD(x0, VW_ROWP(arr, 0, pos)); VW_LOAD(x1, VW_ROWP(arr, 1, pos)); VW_LOAD(x2, VW_ROWP(arr, 2, pos)); VW_LOAD(x3, VW_ROWP(arr, 3, pos)); } while (0)
  u32x2 a0, a1, a2, a3, b0, b1, b2, b3, c0, c1, c2, c3, d0, d1, d2, d3, e0, e1, e2, e3, f0, f1, f2, f3, g0, g1, g2, g3, h0, h1, h2, h3;
  {
    unsigned pk0[4];
#pragma unroll
    for (int k = 0; k < 4; ++k) pk0[k] = pk[k][0];
    VW_LOAD4(a0, a1, a2, a3, pk0, 0); VW_LOAD4(b0, b1, b2, b3, pk0, 1); VW_LOAD4(c0, c1, c2, c3, pk0, 2); VW_LOAD4(d0, d1, d2, d3, pk0, 3); VW_LOAD4(e0, e1, e2, e3, pk0, 4); VW_LOAD4(f0, f1, f2, f3, pk0, 5); VW_LOAD4(g0, g1, g2, g3, pk0, 6);
  }
#pragma unroll 1
  for (int it = 0; it < 128; it += 8) {
    const bool hi_c = (it & 64) != 0, hi_n = ((it + 8) & 64) != 0;
    const int pc = it & 63, pn = (it + 8) & 63;
    unsigned pkc[4], pkn[4]; float cfc[4];
#pragma unroll
    for (int k = 0; k < 4; ++k) { pkc[k] = hi_c ? pk[k][1] : pk[k][0]; pkn[k] = hi_n ? pk[k][1] : pk[k][0]; cfc[k] = hi_c ? coef[k][1] : coef[k][0]; }
    VW_LOAD4(h0, h1, h2, h3, pkc, pc + 7); VW_WAIT(28, a0, a1, a2, a3); comp(a0, a1, a2, a3, cfc, pc + 0);
    VW_LOAD4(a0, a1, a2, a3, pkn, pn + 0); VW_WAIT(28, b0, b1, b2, b3); comp(b0, b1, b2, b3, cfc, pc + 1);
    VW_LOAD4(b0, b1, b2, b3, pkn, pn + 1); VW_WAIT(28, c0, c1, c2, c3); comp(c0, c1, c2, c3, cfc, pc + 2);
    VW_LOAD4(c0, c1, c2, c3, pkn, pn + 2); VW_WAIT(28, d0, d1, d2, d3); comp(d0, d1, d2, d3, cfc, pc + 3);
    VW_LOAD4(d0, d1, d2, d3, pkn, pn + 3); VW_WAIT(28, e0, e1, e2, e3); comp(e0, e1, e2, e3, cfc, pc + 4);
    VW_LOAD4(e0, e1, e2, e3, pkn, pn + 4); VW_WAIT(28, f0, f1, f2, f3); comp(f0, f1, f2, f3, cfc, pc + 5);
    VW_LOAD4(f0, f1, f2, f3, pkn, pn + 5); VW_WAIT(28, g0, g1, g2, g3); comp(g0, g1, g2, g3, cfc, pc + 6);
    VW_LOAD4(g0, g1, g2, g3, pkn, pn + 6); VW_WAIT(28, h0, h1, h2, h3); comp(h0, h1, h2, h3, cfc, pc + 7);
  }
  asm volatile("s_waitcnt vmcnt(0)" : "+v"(a0), "+v"(a1), "+v"(a2), "+v"(a3), "+v"(b0), "+v"(b1), "+v"(b2), "+v"(b3), "+v"(c0), "+v"(c1), "+v"(c2), "+v"(c3), "+v"(d0), "+v"(d1), "+v"(d2), "+v"(d3), "+v"(e0), "+v"(e1), "+v"(e2), "+v"(e3), "+v"(f0), "+v"(f1), "+v"(f2), "+v"(f3), "+v"(g0), "+v"(g1), "+v"(g2), "+v"(g3) :: "memory");
#undef VW_LOAD4
#undef VW_ROWP
  float* dst = do_store ? p.out : (float*)(ws + OFF_QRY);
#pragma unroll
  for (int k = 0; k < TPW; ++k) {
    const float4* o = (const float4*)(p.out + (size_t)(t0 + k) * DM + 16 * lane);
    float4* w = (float4*)(dst + (size_t)(t0 + k) * DM + 16 * lane);
    float4 a[4];
#pragma unroll
    for (int q = 0; q < 4; ++q) a[q] = o[q];
#pragma unroll
    for (int q = 0; q < 4; ++q) {
      a[q].x += y[k][4 * q]; a[q].y += y[k][4 * q + 1]; a[q].z += y[k][4 * q + 2]; a[q].w += y[k][4 * q + 3];
      w[q] = a[q];
    }
  }
}
DI void peer_vwalk_mfma(const Params& p, int t0, int lane, char* wl, bool do_store) {
  char* ws = p.ws;
  const unsigned char* V = (const unsigned char*)(ws + OFF_V8);
  const u16* s_list = (const u16*)wl;
  char* s_img = wl + P7_IMG;
  const unsigned char* s_c8 = (const unsigned char*)(wl + P7_C8);
  const float* s_inv = (const float*)(wl + P7_INV);
  const int b = lane >> 4, n = lane & 15, lr = lane >> 3, lc = lane & 7;
  const bool a_act = ((b & 1) == 0) && (n < 8);
  const int sh = 8 * (n & 3);
  const bool lo4 = n < 4;
  float* dst = do_store ? p.out : (float*)(ws + OFF_QRY);
  f32x4 acc[16];
#pragma unroll
  for (int nt = 0; nt < 16; ++nt) acc[nt] = (f32x4){0.f, 0.f, 0.f, 0.f};
  auto gload = [&](u32x4 (&R)[8], int rr) {
    const int qd = rr >> 4, r = rr & 15;
    const u32x4 ids = *(const u32x4*)(s_list + lr * 128 + 8 * r);
#pragma unroll
    for (int i = 0; i < 8; ++i) {
      const unsigned idx = (ids[i >> 1] >> (16 * (i & 1))) & 0xFFFFu;
      R[i] = *(const u32x4*)(V + (size_t)idx * 512 + 128 * qd + 16 * lc);
    }
  };
  auto stage = [&](const u32x4 (&R)[8]) {
#pragma unroll
    for (int i = 0; i < 8; ++i) {
      char* d = s_img + (8 * i + lr) * 136 + 16 * lc;
      *(u32x2*)d = (u32x2){R[i][0], R[i][1]};
      *(u32x2*)(d + 8) = (u32x2){R[i][2], R[i][3]};
    }
  };
  auto round = [&](int r) {
    const u32x2 cw = *(const u32x2*)(s_c8 + (n & 7) * 128 + 8 * r);
    const unsigned x = cw[0] >> (8 * b), y = cw[1] >> (8 * b);
    const unsigned c0 = a_act ? ((x & 0xFFu) << sh) : 0u, c1 = a_act ? (((x >> 8) & 0xFFu) << sh) : 0u;
    const unsigned c2 = a_act ? ((y & 0xFFu) << sh) : 0u, c3 = a_act ? (((y >> 8) & 0xFFu) << sh) : 0u;
    const i32x8 A = {(int)(lo4 ? c0 : 0u), (int)(lo4 ? 0u : c0), (int)(lo4 ? c1 : 0u), (int)(lo4 ? 0u : c1),
                     (int)(lo4 ? c2 : 0u), (int)(lo4 ? 0u : c2), (int)(lo4 ? c3 : 0u), (int)(lo4 ? 0u : c3)};
#pragma unroll
    for (int nt = 0; nt < 16; ++nt) {
      const i32x2 bb = __builtin_amdgcn_ds_read_tr4_b64_v2i32((i32x2 LAS*)(s_img + (16 * b + n) * 136 + 8 * nt));
      const i32x8 B = {bb[0], bb[1], bb[0], bb[1], 0, 0, 0, 0};
      acc[nt] = __builtin_amdgcn_mfma_scale_f32_16x16x128_f8f6f4(A, B, acc[nt], 0, 4, 0, 0, 0, 0);
    }
  };
  auto flush = [&](int qd) {
    if (b < 2) {
      float inv[4];
#pragma unroll
      for (int i = 0; i < 4; ++i) inv[i] = s_inv[4 * b + i];
#pragma unroll
      for (int n4 = 0; n4 < 16; n4 += 4) {
        float o[4][4];
#pragma unroll
        for (int q = 0; q < 4; ++q)
#pragma unroll
          for (int i = 0; i < 4; ++i) o[q][i] = bf2f(((const u16*)(ws + OFF_X1B))[(size_t)(t0 + 4 * b + i) * DM + 256 * qd + 16 * (n4 + q) + n]);
#pragma unroll
        for (int q = 0; q < 4; ++q)
#pragma unroll
          for (int i = 0; i < 4; ++i) dst[(size_t)(t0 + 4 * b + i) * DM + 256 * qd + 16 * (n4 + q) + n] = fmaf(acc[n4 + q][i], inv[i], o[q][i]);
      }
    }
#pragma unroll
    for (int nt = 0; nt < 16; ++nt) acc[nt] = (f32x4){0.f, 0.f, 0.f, 0.f};
  };
  u32x4 rA[8], rB[8];
  gload(rA, 0); gload(rB, 1);
#pragma unroll 1
  for (int rr = 0; rr < 64; rr += 2) {
    stage(rA);
    gload(rA, (rr + 2 < 64) ? rr + 2 : 0);
    round(rr & 15);
    stage(rB);
    gload(rB, (rr + 3 < 64) ? rr + 3 : 1);
    round((rr + 1) & 15);
    if ((rr & 15) == 14) flush(rr >> 4);
  }
}
DI void peer_gather8(const Params& p, int t0, int lane, char* wl, bool do_store, int mode = 3) {
  asm volatile("v_mbcnt_lo_u32_b32 %0, -1, 0\n\tv_mbcnt_hi_u32_b32 %0, -1, %0" : "=v"(lane));
  char* ws = p.ws;
  const unsigned char* U = (const unsigned char*)(ws + OFF_U8);
  u16* s_list = (u16*)wl;
  unsigned char* s_x = (unsigned char*)(wl + 2048);
  float* s_dot = (float*)(wl + P7_DOT);
  unsigned pk[8][2];
  {
    bf16x8 xa[8], xb[8]; float sp[8];
#pragma unroll
    for (int k = 0; k < 8; ++k) {
      const int t = t0 + k;
      const unsigned* sel = (const unsigned*)(ws + OFF_SEL) + (size_t)t * 128;
      pk[k][0] = sel[lane]; pk[k][1] = sel[64 + lane];
      const u16* xr = (const u16*)(ws + OFF_X1B) + (size_t)t * DM + 16 * lane;
      xa[k] = *(const bf16x8*)xr; xb[k] = *(const bf16x8*)(xr + 8);
      sp[k] = (lane < 16) ? ((const float*)(ws + OFF_SSQ))[(size_t)t * 16 + lane] : 0.f;
    }
    __builtin_amdgcn_sched_barrier(0);
    sort_all8<128>(pk, lane);
#pragma unroll
    for (int k = 0; k < 8; ++k) {
      s_list[k * 128 + lane] = (u16)(pk[k][0] >> 18); s_list[k * 128 + 64 + lane] = (u16)(pk[k][1] >> 18);
      const float sc = rsqrtf(wave_total(sp[k]) * (1.f / 1024.f) + EPS) * 16.f;
      const bf16x8 xa_ = xa[k], xb_ = xb[k];
      int w0 = __builtin_amdgcn_cvt_pk_fp8_f32(bf2f(xa_[0]) * sc, bf2f(xa_[1]) * sc, 0, false); w0 = __builtin_amdgcn_cvt_pk_fp8_f32(bf2f(xa_[2]) * sc, bf2f(xa_[3]) * sc, w0, true);
      int w1 = __builtin_amdgcn_cvt_pk_fp8_f32(bf2f(xa_[4]) * sc, bf2f(xa_[5]) * sc, 0, false); w1 = __builtin_amdgcn_cvt_pk_fp8_f32(bf2f(xa_[6]) * sc, bf2f(xa_[7]) * sc, w1, true);
      int w2 = __builtin_amdgcn_cvt_pk_fp8_f32(bf2f(xb_[0]) * sc, bf2f(xb_[1]) * sc, 0, false); w2 = __builtin_amdgcn_cvt_pk_fp8_f32(bf2f(xb_[2]) * sc, bf2f(xb_[3]) * sc, w2, true);
      int w3 = __builtin_amdgcn_cvt_pk_fp8_f32(bf2f(xb_[4]) * sc, bf2f(xb_[5]) * sc, 0, false); w3 = __builtin_amdgcn_cvt_pk_fp8_f32(bf2f(xb_[6]) * sc, bf2f(xb_[7]) * sc, w3, true);
      *(uint4*)(s_x + k * 1024 + 16 * lane) = make_uint4((unsigned)w0, (unsigned)w1, (unsigned)w2, (unsigned)w3);
    }
  }
  asm volatile("s_waitcnt lgkmcnt(0)" ::: "memory");
  if (mode & 1) {
    const int g = lane >> 4, jc = lane & 15, tok = lane & 7, uu = (lane >> 3) & 1;
    i32x8 xfr[8];
#pragma unroll
    for (int c = 0; c < 8; ++c) {
      const int o0 = 256 * (g >> 1) + 32 * c + 16 * (g & 1);
      const i32x4 x0 = *(const i32x4*)(s_x + tok * 1024 + o0), x1 = *(const i32x4*)(s_x + tok * 1024 + o0 + 512);
      xfr[c] = __builtin_shufflevector(x0, x1, 0, 1, 2, 3, 4, 5, 6, 7);
    }
    asm volatile("s_waitcnt lgkmcnt(0)" ::: "memory");
    const bool keep = (g == ((lane >> 2) & 1));
    char* s_stage = (char*)s_x;
    const int jl = lane >> 5, cl = lane & 31, gl = cl >> 3, cpl = cl & 7;
    auto gload = [&](u32x4 (&R)[8], int step) {
#pragma unroll
      for (int i = 0; i < 8; ++i) {
        const int j = 2 * i + jl;
        const unsigned idx = s_list[(j & 7) * 128 + 2 * step + (j >> 3)];
        R[i] = *(const u32x4*)(U + (size_t)idx * 512 + 16 * cl);
      }
    };
    auto stage = [&](const u32x4 (&R)[8]) {
#pragma unroll
      for (int i = 0; i < 8; ++i) {
        const int j = 2 * i + jl;
        *(u32x4*)(s_stage + gl * 2048 + j * 128 + ((cpl + (j >> 1)) & 7) * 16) = R[i];
      }
    };
    f32x4 acc = {0.f, 0.f, 0.f, 0.f};
#define P7_COMP() do { _Pragma("unroll") for (int c = 0; c < 8; ++c) { \
        const i32x4 b = *(const i32x4*)(s_stage + g * 2048 + jc * 128 + ((c + (jc >> 1)) & 7) * 16); \
        const i32x8 b8 = {b[0], b[1], b[2], b[3], 0, 0, 0, 0}; \
        acc = __builtin_amdgcn_mfma_scale_f32_16x16x128_f8f6f4(xfr[c], b8, acc, 0, 4, 0, 0, 0, 0); } } while (0)
#define P7_KEEP(ST) do { const int sel2 = lane & 3; \
      const float v = sel2 == 0 ? acc[0] : sel2 == 1 ? acc[1] : sel2 == 2 ? acc[2] : acc[3]; \
      if (keep) s_dot[tok * 128 + 2 * (ST) + uu] = v; \
      acc = (f32x4){0.f, 0.f, 0.f, 0.f}; } while (0)
    u32x4 rA[8], rB[8];
    gload(rA, 0); gload(rB, 1);
#pragma unroll 1
    for (int st = 0; st < 64; st += 2) {
      stage(rA);
      gload(rA, (st + 2 < 64) ? st + 2 : 0);
      P7_COMP();
      P7_KEEP(st);
      stage(rB);
      gload(rB, (st + 3 < 64) ? st + 3 : 1);
      P7_COMP();
      P7_KEEP(st + 1);
    }
  }
  asm volatile("s_waitcnt lgkmcnt(0)" ::: "memory");
  {
    unsigned char* s_c8 = (unsigned char*)(wl + P7_C8);
    float* s_inv = (float*)(wl + P7_INV);
#pragma unroll
    for (int k = 0; k < 8; ++k) {
      float cf[2];
#pragma unroll
      for (int rg = 0; rg < 2; ++rg) {
        const float d = s_dot[k * 128 + 64 * rg + lane] * (((const float*)(ws + OFF_RSU))[pk[k][rg] >> 18] * (1.f / 16.f));
        const float act = 0.5f * d * (1.f + erff(d * 0.7071067811865476f));
        const float gate = __uint_as_float((pk[k][rg] & 0x3FFFFu) << 13);
        cf[rg] = gate * act * ((const float*)(ws + OFF_RSV))[pk[k][rg] >> 18];
      }
      const float m = wave_max_pos(fmaxf(fabsf(cf[0]), fabsf(cf[1])));
      const float S = m > 0.f ? 384.f / m : 0.f;
#pragma unroll
      for (int rg = 0; rg < 2; ++rg)
        s_c8[k * 128 + 64 * rg + lane] = (unsigned char)(__builtin_amdgcn_cvt_pk_fp8_f32(cf[rg] * S, 0.f, 0, false) & 0xFF);
      if (lane == 0) s_inv[k] = m * (1.f / 384.f);
    }
  }
  asm volatile("s_waitcnt lgkmcnt(0)" ::: "memory");
  if (mode & 2) peer_vwalk_mfma(p, t0, lane, wl, do_store);
}
DI void phase7(const Params& p, int bid, int nb, int tid, char* smem, bool do_store, int mode = 3) {
  const int lane = tid & 63, w = __builtin_amdgcn_readfirstlane(tid >> 6), gw = bid * 8 + w, nw = nb * 8;
  char* wl = smem + 1024 + w * P7_WLDS;
  for (int g = gw; g < T_ / 8; g += nw) peer_gather8(p, g * 8, lane, wl, do_store, mode);
}

#ifndef PROBE_MODE2
#define PROBE_MODE2 3
#endif
#ifndef ONLYP
#define ONLYP -1
#endif
#ifndef PROBE_REP
#define PROBE_REP 0
#endif
#ifndef REP_PHASE
#define REP_PHASE -1
#endif
constexpr int LDS_BYTES = LDS_GEMM_OFF + 2 * G_STAGE_B;

DI Params phase_params() {
  const char* ka = (const char*)__builtin_amdgcn_kernarg_segment_ptr();
  asm volatile("" : "+s"(ka));
  return *(const Params*)ka;
}
__global__ void __launch_bounds__(NTHR, 2) mega(Params p, int ph_lo, int ph_hi, int rep) {
  __shared__ __attribute__((aligned(16))) char smem[LDS_BYTES];
  const int tid = threadIdx.x, bid = blockIdx.x, nb = gridDim.x;
  if (tid == 0) *(uint4*)smem = make_uint4(0u, 0u, 0u, 0u);
  __syncthreads();
  XcdBarrier bar;
  const bool multi = ph_hi > ph_lo;
  if (multi) bar = xcd_barrier_post((unsigned*)(p.ws + OFF_BAR), (volatile LAS unsigned*)smem);
  if ((ONLYP < 0 || ONLYP == 0) && ph_lo <= 0 && 0 <= ph_hi) { if (PROBE_REP && REP_PHASE == 0) { phase0(p, bid, nb, tid); __syncthreads(); } phase0(p, bid, nb, tid); if (ph_hi > 0) xcd_barrier(bar); }
  if ((ONLYP < 0 || ONLYP == 1) && ph_lo <= 1 && 1 <= ph_hi) { if (PROBE_REP && REP_PHASE == 1) { phase1(p, bid, nb, tid, smem); __syncthreads(); } phase1(p, bid, nb, tid, smem); if (ph_hi > 1) xcd_barrier(bar); }
  if ((ONLYP < 0 || ONLYP == 2) && ph_lo <= 2 && 2 <= ph_hi) { if (PROBE_REP && REP_PHASE == 2) { phase2(p, bid, nb, tid, smem, PROBE_MODE2 | 4); __syncthreads(); } phase2(p, bid, nb, tid, smem); if (ph_hi > 2) xcd_barrier(bar); }
  if ((ONLYP < 0 || ONLYP == 3) && ph_lo <= 3 && 3 <= ph_hi) { if (PROBE_REP && REP_PHASE == 3) { phase3(p, bid, nb, tid, smem, PROBE_MODE2); __syncthreads(); } phase3(p, bid, nb, tid, smem); if (ph_hi > 3) xcd_barrier(bar); }
  if ((ONLYP < 0 || ONLYP == 4) && ph_lo <= 4 && 4 <= ph_hi) { if (PROBE_REP && REP_PHASE == 4) { phase4(p, bid, nb, tid, smem); __syncthreads(); } phase4(p, bid, nb, tid, smem); if (ph_hi > 4) xcd_barrier(bar); }
  if ((ONLYP < 0 || ONLYP == 5) && ph_lo <= 5 && 5 <= ph_hi) { if (PROBE_REP && REP_PHASE == 5) { phase5(p, bid, nb, tid, smem); __syncthreads(); } phase5(p, bid, nb, tid, smem); if (ph_hi > 5) xcd_barrier(bar); }
  if ((ONLYP < 0 || ONLYP == 7) && ph_lo <= 7 && 7 <= ph_hi) { if (PROBE_REP && REP_PHASE == 7) phase7(p, bid, nb, tid, smem, ph_hi < 0, PROBE_MODE2); phase7(p, bid, nb, tid, smem, true); }
}

#ifndef ONLYP
#define ONLYP -1
#endif
#ifndef PROBE_REP
#define PROBE_REP 0
#endif
#ifndef REP_PHASE
#define REP_PHASE -1
#endif
#ifndef MK_LAUNCHES
#define MK_LAUNCHES 1
#endif

extern "C" void kernel_launch(void* const* d_in, const int* in_sizes, int n_in, void* d_out, int out_size, void* d_ws, size_t ws_size,
                              hipStream_t stream) {
  (void)in_sizes; (void)n_in; (void)out_size; (void)ws_size;
  static int grid = 0;
  if (!grid) {
    int dev = 0, cus = 0;
    (void)hipGetDevice(&dev);
    (void)hipDeviceGetAttribute(&cus, hipDeviceAttributeMultiprocessorCount, dev);
    int per_cu = 0;
    (void)hipOccupancyMaxActiveBlocksPerMultiprocessor(&per_cu, (const void*)mega, NTHR, 0);
    if (per_cu < 1) per_cu = 1;
    grid = cus > 0 ? cus : 256;
  }
  Params p{};
  p.x = (const float*)d_in[0]; p.pos = (const int*)d_in[1]; p.attn_g = (const float*)d_in[2]; p.w_in = (const float*)d_in[3];
  p.b_i = (const float*)d_in[4]; p.b_f = (const float*)d_in[5]; p.mn_g = (const float*)d_in[6]; p.cq_g = (const float*)d_in[7];
  p.w_uq = (const float*)d_in[8]; p.ckv_g = (const float*)d_in[9]; p.w_ukv = (const float*)d_in[10]; p.q_g = (const float*)d_in[11];
  p.k_g = (const float*)d_in[12]; p.w_out = (const float*)d_in[13]; p.ffn_g = (const float*)d_in[14]; p.pwq = (const float*)d_in[15];
  p.k1 = (const float*)d_in[16]; p.k2 = (const float*)d_in[17]; p.pu = (const float*)d_in[18]; p.pv = (const float*)d_in[19];
  p.out = (float*)d_out; p.ws = (char*)d_ws;
  (void)hipMemsetAsync(d_ws, 0, 16384, stream);
#if MK_LAUNCHES == 1
  hipLaunchKernelGGL(mega, dim3(grid), dim3(NTHR), 0, stream, p, 0, 7, REP_PHASE);
#else
  for (int ph = 0; ph < 8; ++ph) hipLaunchKernelGGL(mega, dim3(grid), dim3(NTHR), 0, stream, p, ph, ph, REP_PHASE);
#endif
}
```
